# Optimizing an MI355X kernel written in HIP

```python
import math
import jax, jax.numpy as jnp
from jax import lax
import numpy as np

D_MODEL = 1024
BATCH = 4
SEQ = 4096
DEPTH = 2

MEM_LEN = 256
EPS = 1e-6
SB_HEADS = 8
SB_HEAD_DIM = 64
SB_WIDTH = SB_HEADS * SB_HEAD_DIM
SB_BLOCK = 128
GLA_HEADS = 4
GLA_DK = 64
GLA_DV = 128
GLA_KW = GLA_HEADS * GLA_DK
GLA_VW = GLA_HEADS * GLA_DV
GLA_GATE_RANK = 16
GLA_GATE_TAU = 16.0
GLA_CHUNK = 64
CA_HEADS = 4
CA_HEAD_DIM = 128
CA_WIDTH = CA_HEADS * CA_HEAD_DIM
N_BRANCH = 3
IN_SPLITS = (SB_WIDTH, SB_WIDTH, SB_WIDTH, GLA_KW, GLA_KW, GLA_VW, GLA_GATE_RANK, GLA_VW, CA_WIDTH, N_BRANCH * D_MODEL)
IN_WIDTH = 3 * SB_WIDTH + 2 * GLA_KW + 2 * GLA_VW + GLA_GATE_RANK + CA_WIDTH + N_BRANCH * D_MODEL
D_FF = 2816
N_EXPERTS = 8
TOP_K = 2
D_FF_EXPERT = 3584
N_DENSE = (DEPTH + 1) // 2
N_MOE = DEPTH // 2

kernel_name = 'hybrid_sb_gla_memxattn_moe_trunk'


def rms_norm(x, g):
    xf = x.astype(jnp.float32)
    y = xf * lax.rsqrt(jnp.mean(xf * xf, axis=-1, keepdims=True) + EPS)
    return (y * g.astype(jnp.float32)).astype(x.dtype)


def split_heads(t, n):
    b, s, w = t.shape
    return t.reshape(b, s, n, w // n).transpose(0, 2, 1, 3)


def merge_heads(t):
    b, h, s, d = t.shape
    return t.transpose(0, 2, 1, 3).reshape(b, s, h * d)


def stick_breaking_attention(q, k, v):
    s_len, d = q.shape[2], q.shape[3]
    scale = d ** -0.5
    outs = []
    for i in range(s_len // SB_BLOCK):
        q0 = i * SB_BLOCK
        q1 = q0 + SB_BLOCK
        qb = q[:, :, q0:q1].astype(jnp.float32)
        kb = k[:, :, :q1].astype(jnp.float32)
        z = jnp.einsum('bhtd,bhsd->bhts', qb, kb) * scale
        causal = jnp.arange(q1)[None, :] < jnp.arange(q0, q1)[:, None]
        log_beta = jax.nn.log_sigmoid(z)
        log_1m_beta = jnp.where(causal, log_beta - z, 0.0)
        tail = lax.cumsum(log_1m_beta, axis=3, reverse=True) - log_1m_beta
        w = jnp.where(causal, jnp.exp(log_beta + tail), 0.0)
        outs.append(jnp.einsum('bhts,bhsd->bhtd', w.astype(v.dtype), v[:, :, :q1]))
    return jnp.concatenate(outs, axis=2)


def gla_chunked(q, k, v, log_a):
    b_, h_, s_len, dk = q.shape
    dv = v.shape[-1]
    c = GLA_CHUNK
    n = s_len // c
    qf = q.astype(jnp.float32).reshape(b_, h_, n, c, dk) * (dk ** -0.5)
    kf = k.astype(jnp.float32).reshape(b_, h_, n, c, dk)
    vf = v.astype(jnp.float32).reshape(b_, h_, n, c, dv)
    cum = jnp.cumsum(log_a.astype(jnp.float32).reshape(b_, h_, n, c, dk), axis=3)
    cum_last = cum[:, :, :, -1:, :]
    q_dec = qf * jnp.exp(cum)
    k_inv = kf * jnp.exp(-cum)
    k_end = kf * jnp.exp(cum_last - cum)
    tri = jnp.tril(jnp.ones((c, c), dtype=bool))
    scores = jnp.where(tri, jnp.einsum('bhnid,bhnjd->bhnij', q_dec, k_inv), 0.0)
    o_intra = jnp.einsum('bhnij,bhnjv->bhniv', scores, vf)
    kv_chunk = jnp.einsum('bhnjd,bhnjv->bhndv', k_end, vf)
    decay_chunk = jnp.exp(cum_last[:, :, :, 0, :])

    def step(state, inp):
        dec, kv = inp
        return dec[..., None] * state + kv, state

    _, states = lax.scan(step, jnp.zeros((b_, h_, dk, dv), jnp.float32),
                         (jnp.moveaxis(decay_chunk, 2, 0), jnp.moveaxis(kv_chunk, 2, 0)))
    states = jnp.moveaxis(states, 0, 2)
    o_inter = jnp.einsum('bhnid,bhndv->bhniv', q_dec, states)
    return (o_intra + o_inter).reshape(b_, h_, s_len, dv).astype(v.dtype)


def memory_cross_attention(q, mk, mv):
    d = q.shape[-1]
    s = jnp.einsum('bhtd,bhmd->bhtm', q.astype(jnp.float32), mk.astype(jnp.float32)) * (d ** -0.5)
    p = jax.nn.softmax(s, axis=-1)
    return jnp.einsum('bhtm,bhmd->bhtd', p.astype(mv.dtype), mv)


def hybrid_mixer(x, mem, norm_g, w_in, sb_q_g, sb_k_g, gla_a_up, gla_a_b, gla_o_g, ca_q_g, ca_k_g,
                 mem_norm_g, w_mem_kv, w_br_sb, w_br_gla, w_br_ca, w_out):
    b_, s_len, dm = x.shape
    h = rms_norm(x, norm_g)
    proj = h @ w_in
    offsets = np.cumsum(IN_SPLITS)[:-1].tolist()
    sb_q, sb_k, sb_v, g_q, g_k, g_v, g_a, g_r, ca_q, gates = jnp.split(proj, offsets, axis=-1)

    q_a = rms_norm(split_heads(sb_q, SB_HEADS), sb_q_g)
    k_a = rms_norm(split_heads(sb_k, SB_HEADS), sb_k_g)
    o_a = merge_heads(stick_breaking_attention(q_a, k_a, split_heads(sb_v, SB_HEADS)))

    log_a = jax.nn.log_sigmoid((g_a @ gla_a_up + gla_a_b).astype(jnp.float32)) / GLA_GATE_TAU
    o_b = gla_chunked(split_heads(g_q, GLA_HEADS), split_heads(g_k, GLA_HEADS),
                      split_heads(g_v, GLA_HEADS), split_heads(log_a, GLA_HEADS))
    o_b = merge_heads(rms_norm(o_b, gla_o_g)) * jax.nn.silu(g_r)

    mkv = rms_norm(mem, mem_norm_g) @ w_mem_kv
    m_k, m_v = jnp.split(mkv, 2, axis=-1)
    q_c = rms_norm(split_heads(ca_q, CA_HEADS), ca_q_g)
    k_c = rms_norm(split_heads(m_k, CA_HEADS), ca_k_g)
    o_c = merge_heads(memory_cross_attention(q_c, k_c, split_heads(m_v, CA_HEADS)))

    g = jax.nn.sigmoid(gates.astype(jnp.float32)).astype(x.dtype).reshape(b_, s_len, N_BRANCH, dm)
    merged = g[:, :, 0] * (o_a @ w_br_sb) + g[:, :, 1] * (o_b @ w_br_gla) + g[:, :, 2] * (o_c @ w_br_ca)
    return merged @ w_out


def swiglu(h, w_gate_up, w_down):
    gt, up = jnp.split(h @ w_gate_up, 2, axis=-1)
    return (jax.nn.silu(gt) * up) @ w_down


def moe_swiglu(h, w_router, w_gate_up, w_down):
    b_, s_len, dm = h.shape
    t = h.reshape(-1, dm)
    logits = (t @ w_router).astype(jnp.float32)
    top_val, top_idx = lax.top_k(logits, TOP_K)
    top_w = jax.nn.softmax(top_val, axis=-1)
    combine = jnp.sum(jax.nn.one_hot(top_idx, N_EXPERTS, dtype=jnp.float32) * top_w[..., None], axis=1)
    combine = combine.astype(t.dtype)
    y = jnp.zeros_like(t)
    for e in range(N_EXPERTS):
        y = y + combine[:, e:e + 1] * swiglu(t, w_gate_up[e], w_down[e])
    return y.reshape(b_, s_len, dm)


def setup_inputs(seed: int = 0) -> dict:
    key = jax.random.key(seed)
    ks = jax.random.split(key, 24)
    f32 = jnp.float32
    L = DEPTH

    def nrm(k, shape, fan_in):
        return jax.random.normal(k, shape, f32) * (fan_in ** -0.5)

    def gain(k, shape):
        return 1.0 + 0.1 * jax.random.normal(k, shape, f32)

    return {
        'x': jax.random.normal(ks[0], (BATCH, SEQ, D_MODEL), f32),
        'mem': jax.random.normal(ks[1], (BATCH, MEM_LEN, D_MODEL), f32),
        'mix_norm_g': gain(ks[2], (L, D_MODEL)),
        'w_in': nrm(ks[3], (L, D_MODEL, IN_WIDTH), D_MODEL),
        'sb_q_g': gain(ks[4], (L, SB_HEAD_DIM)),
        'sb_k_g': gain(ks[5], (L, SB_HEAD_DIM)),
        'gla_a_up': nrm(ks[6], (L, GLA_GATE_RANK, GLA_KW), GLA_GATE_RANK),
        'gla_a_b': 0.1 * jax.random.normal(ks[7], (L, GLA_KW), f32),
        'gla_o_g': gain(ks[8], (L, GLA_DV)),
        'ca_q_g': gain(ks[9], (L, CA_HEAD_DIM)),
        'ca_k_g': gain(ks[10], (L, CA_HEAD_DIM)),
        'mem_norm_g': gain(ks[11], (L, D_MODEL)),
        'w_mem_kv': nrm(ks[12], (L, D_MODEL, 2 * CA_WIDTH), D_MODEL),
        'w_br_sb': nrm(ks[13], (L, SB_WIDTH, D_MODEL), SB_WIDTH),
        'w_br_gla': nrm(ks[14], (L, GLA_VW, D_MODEL), GLA_VW),
        'w_br_ca': nrm(ks[15], (L, CA_WIDTH, D_MODEL), CA_WIDTH),
        'w_out': nrm(ks[16], (L, D_MODEL, D_MODEL), D_MODEL),
        'ffn_norm_g': gain(ks[17], (L, D_MODEL)),
        'ff_w_gate_up': nrm(ks[18], (N_DENSE, D_MODEL, 2 * D_FF), D_MODEL),
        'ff_w_down': nrm(ks[19], (N_DENSE, D_FF, D_MODEL), D_FF),
        'moe_w_router': nrm(ks[20], (N_MOE, D_MODEL, N_EXPERTS), D_MODEL),
        'moe_w_gate_up': nrm(ks[21], (N_MOE, N_EXPERTS, D_MODEL, 2 * D_FF_EXPERT), D_MODEL),
        'moe_w_down': nrm(ks[22], (N_MOE, N_EXPERTS, D_FF_EXPERT, D_MODEL), D_FF_EXPERT),
    }


def reference(x, mem, mix_norm_g, w_in, sb_q_g, sb_k_g, gla_a_up, gla_a_b, gla_o_g, ca_q_g, ca_k_g,
              mem_norm_g, w_mem_kv, w_br_sb, w_br_gla, w_br_ca, w_out, ffn_norm_g,
              ff_w_gate_up, ff_w_down, moe_w_router, moe_w_gate_up, moe_w_down):
    for layer in range(DEPTH):
        x = x + hybrid_mixer(x, mem, mix_norm_g[layer], w_in[layer], sb_q_g[layer], sb_k_g[layer],
                             gla_a_up[layer], gla_a_b[layer], gla_o_g[layer], ca_q_g[layer], ca_k_g[layer],
                             mem_norm_g[layer], w_mem_kv[layer], w_br_sb[layer], w_br_gla[layer],
                             w_br_ca[layer], w_out[layer])
        h = rms_norm(x, ffn_norm_g[layer])
        j = layer // 2
        if layer % 2 == 0:
            x = x + swiglu(h, ff_w_gate_up[j], ff_w_down[j])
        else:
            x = x + moe_swiglu(h, moe_w_router[j], moe_w_gate_up[j], moe_w_down[j])
    return x
```

```cpp
#include <hip/hip_runtime.h>
#include <cstdio>
#include <cstdint>

#ifndef PG8_SP2
#define PG8_SP2 true
#endif
#ifndef DBG_REP_SB
#define DBG_REP_SB 1
#endif
#ifndef L1_INPROJ_FP8
#define L1_INPROJ_FP8 0
#endif
#ifndef MK_ONE_LAUNCH
#define MK_ONE_LAUNCH 1
#endif

constexpr int DM = 1024, BATCH = 4, SEQ = 4096, MTOK = BATCH * SEQ, MEMLEN = 256, MMEM = BATCH * MEMLEN;
constexpr int IN_W = 6672, IN_WP = 6912;
constexpr int DFF = 2816, NEXP = 8, DFFE = 3584;
constexpr float EPS = 1e-6f;
constexpr float LOG2E = 1.4426950408889634f;
constexpr int MOE_ROWS = 2 * MTOK + NEXP * 256;

constexpr size_t MiB = 1u << 20;
constexpr size_t WS_CTL = 0, CTL_ZERO_BYTES = 1 * MiB;
constexpr size_t WS_WIN = 2 * MiB;
constexpr size_t WS_WMKV = WS_WIN + 27 * MiB;
constexpr size_t WS_WBR = WS_WMKV + 4 * MiB;
constexpr size_t WS_WOUT = WS_WBR + 6 * MiB;
constexpr size_t WS_WGU0 = WS_WOUT + 4 * MiB;
constexpr size_t WS_WDN0 = WS_WGU0 + 11 * MiB;
constexpr size_t WS_WGUE = WS_WDN0 + 6 * MiB;
constexpr size_t WS_WDNE = WS_WGUE + 112 * MiB;
constexpr size_t WS_HBUF = WS_WDNE + 56 * MiB;
constexpr size_t WS_HMEM = WS_HBUF + 32 * MiB;
constexpr size_t WS_MK = WS_HMEM + 4 * MiB;
constexpr size_t WS_MV = WS_MK + 2 * MiB;
constexpr size_t WS_ROUTE = WS_MV + 2 * MiB;
constexpr size_t WS_ASORT = WS_ROUTE + 1 * MiB;
constexpr size_t WS_YPART = WS_ASORT;
constexpr int YPART_ROWS = 2560;
constexpr size_t WS_YBUF = WS_ASORT + 68 * MiB;
constexpr size_t WS_HB8 = WS_YBUF + 68 * MiB;
constexpr size_t WS_ACT0 = WS_HB8 + 16 * MiB;
constexpr size_t WS_SBQ = WS_ACT0;
constexpr size_t WS_SBK = WS_SBQ + 16 * MiB;
constexpr size_t WS_SBV = WS_SBK + 16 * MiB;
constexpr size_t WS_GQ = WS_SBV + 16 * MiB;
constexpr size_t WS_GK = WS_GQ + 8 * MiB;
constexpr size_t WS_GV = WS_GK + 8 * MiB;
constexpr size_t WS_LOGA = WS_GV + 16 * MiB;
constexpr size_t WS_GR = WS_LOGA + 16 * MiB;
constexpr size_t WS_CAQ = WS_GR + 16 * MiB;
constexpr size_t WS_GATES = WS_CAQ + 16 * MiB;
constexpr size_t WS_OCAT = WS_GATES + 96 * MiB;
constexpr size_t WS_KV = WS_OCAT + 48 * MiB;
constexpr size_t WS_DEC = WS_KV + 32 * MiB;
constexpr size_t WS_STATE = WS_DEC + 1 * MiB;
constexpr size_t WS_MERGED = WS_STATE + 16 * MiB;
constexpr size_t WS_MIX_END = WS_MERGED + 32 * MiB;
constexpr size_t WS_ACT = WS_ACT0;
constexpr size_t WS_END = WS_MIX_END;
static_assert(WS_ACT + (size_t)MOE_ROWS * DFFE * 2 <= WS_END, "MoE act fits the overlay");
static_assert(WS_END <= 896 * MiB, "d_ws budget");

constexpr int CW_TMO = 0;
constexpr int CW_BAR = 4096;
constexpr int CW_CNT = 32768;

constexpr int RING_BYTES = 131072;
constexpr int LDSCTL_OFF = RING_BYTES, MISC_OFF = LDSCTL_OFF + 320;
constexpr int XS_OFF = RING_BYTES + 1024;
constexpr int LDS_BYTES = 147456;

#define GAS __attribute__((address_space(1)))
#define LAS __attribute__((address_space(3)))
typedef unsigned short bf16;
typedef unsigned v4u __attribute__((ext_vector_type(4)));
typedef unsigned v2u __attribute__((ext_vector_type(2)));
typedef float f32x4 __attribute__((ext_vector_type(4)));
typedef float f32x16 __attribute__((ext_vector_type(16)));
typedef short bf16x8 __attribute__((ext_vector_type(8)));
typedef short s16x4 __attribute__((ext_vector_type(4)));
typedef GAS unsigned gu32;
#define RLX_AGENT __ATOMIC_RELAXED, __HIP_MEMORY_SCOPE_AGENT
#define LDS_WAIT() asm volatile("s_waitcnt lgkmcnt(0)" ::: "memory")
#define VM_WAIT() asm volatile("s_waitcnt vmcnt(0)" ::: "memory")

__device__ __forceinline__ unsigned f2bf(float f) { unsigned u = __builtin_bit_cast(unsigned, f); return (u + 0x7fffu + ((u >> 16) & 1u)) >> 16; }
__device__ __forceinline__ unsigned pk2(float lo, float hi) { return f2bf(lo) | (f2bf(hi) << 16); }
__device__ __forceinline__ float bf2f(unsigned short b) { return __builtin_bit_cast(float, (unsigned)b << 16); }
__device__ __forceinline__ float bflo(unsigned w) { return __builtin_bit_cast(float, w << 16); }
__device__ __forceinline__ float bfhi(unsigned w) { return __builtin_bit_cast(float, w & 0xffff0000u); }
typedef float f32x2_t __attribute__((ext_vector_type(2))); typedef __bf16 bf16x2_t __attribute__((ext_vector_type(2)));
__device__ __forceinline__ unsigned cvt_pk_bf16(float lo, float hi) { f32x2_t v = {lo, hi}; bf16x2_t b = __builtin_convertvector(v, bf16x2_t); return __builtin_bit_cast(unsigned, b); }
__device__ __forceinline__ unsigned pk4_fp8(float a, float b, float c, float d) {
    a = __builtin_amdgcn_fmed3f(a, -448.f, 448.f); b = __builtin_amdgcn_fmed3f(b, -448.f, 448.f); c = __builtin_amdgcn_fmed3f(c, -448.f, 448.f); d = __builtin_amdgcn_fmed3f(d, -448.f, 448.f);
    int r = __builtin_amdgcn_cvt_pk_fp8_f32(a, b, 0, false); r = __builtin_amdgcn_cvt_pk_fp8_f32(c, d, r, true); return (unsigned)r; }
__device__ __forceinline__ float ex2(float x) { return __builtin_amdgcn_exp2f(x); }
__device__ __forceinline__ float lg2(float x) { return __builtin_amdgcn_logf(x); }
__device__ __forceinline__ float rcpf_(float x) { return __builtin_amdgcn_rcpf(x); }
__device__ __forceinline__ float sigmoidf_(float x) { return rcpf_(1.f + ex2(-x * LOG2E)); }
__device__ __forceinline__ int lane_fresh() { unsigned m = ~0u; asm volatile("" : "+s"(m)); return (int)__builtin_amdgcn_mbcnt_hi(m, __builtin_amdgcn_mbcnt_lo(m, 0u)); }
template <int K> __device__ __forceinline__ float swz_xor(float x) { return __int_as_float(__builtin_amdgcn_ds_swizzle(__float_as_int(x), (K << 10) | 0x1f)); }
__device__ __forceinline__ float other_half(float x, int hi) { const auto rr = __builtin_amdgcn_permlane32_swap(__float_as_uint(x), __float_as_uint(x), false, false); return __uint_as_float(hi ? rr[0] : rr[1]); }
__device__ __forceinline__ float wave_sum(float v, int hi) {
    v += swz_xor<1>(v); v += swz_xor<2>(v); v += swz_xor<4>(v); v += swz_xor<8>(v); v += swz_xor<16>(v); v += other_half(v, hi); return v;
}
__device__ __forceinline__ int crow(int r, int hi) { return (r & 3) + 8 * (r >> 2) + 4 * hi; }

namespace pg8 {
#define PG8_LAS __attribute__((address_space(3)))
typedef unsigned short bf16_t;
constexpr int BM = 256, BK = 64, HALF = 128, HTB = HALF * BK * 2, STAGE_BYTES = 8 * HTB, NXCD = 8, WGM = 8;
__host__ __device__ __forceinline__ int lds_byte(int r, int c) { const int st = (r >> 4) * 2 + (c >> 5), rr = r & 15, cc = c & 31, ob = rr * 64 + cc * 2; return st * 1024 + (ob ^ (((ob >> 9) & 1) << 5)); }
__host__ __device__ __forceinline__ void stage_rc(int b, int& R, int& C) { const int st = b / 1024, sb = b % 1024, swz = sb ^ (((sb >> 9) & 1) << 5); R = (st >> 1) * 16 + swz / 64; C = (st & 1) * 32 + (swz % 64) / 2; }
__host__ __device__ __forceinline__ int perm32(int rho) { const int n = rho >> 4, i = rho & 15; return 8 * (i >> 2) + 4 * n + (i & 3); }

struct Unit { int pm, pn, e; };
struct Gemm { const bf16_t* A; const bf16_t* Bt; int M, N, K; size_t bgs; int KP; };

struct StaticOrder {
    int nM, nN, nwg, G, c;
    __host__ __device__ void init(int M, int N, int G_, int c_) { nM = M / BM; nN = N / BM; nwg = nM * nN; G = G_; c = c_; }
    __host__ __device__ bool next(int i, Unit& u) const {
        const long L = (long)i * G + c; if (L >= nwg) return false;
        int wgid = (int)L; { const int q = nwg / NXCD, r = nwg % NXCD, xcd = wgid % NXCD, off = wgid / NXCD; wgid = (xcd < r ? xcd * (q + 1) : r * (q + 1) + (xcd - r) * q) + off; }
        const int nig = WGM * nN, gid = wgid / nig, fm = gid * WGM, gsz = (nM - fm) < WGM ? (nM - fm) : WGM;
        u.pm = fm + ((wgid % nig) % gsz); u.pn = (wgid % nig) / gsz; u.e = 0; return true;
    }
};
struct GroupedOrder {
    StaticOrder so; int ts[9];
    __device__ void init(const unsigned* cnt, int N, int G_, int c_) {
        int t = 0;
#pragma unroll
        for (int e = 0; e < 8; ++e) { ts[e] = t; t += ((int)cnt[e * 64] + 255) >> 8; }
        ts[8] = t; so.init(t * BM, N, G_, c_);
    }
    static constexpr int KSPL = 7;
    __device__ static int main_tiles(int t, int nN, int G_) { const int tm = ((t * nN) / G_) * G_ / nN; return ((t - tm) * nN * KSPL <= G_) ? tm : t; }
    __device__ void init_main(const unsigned* cnt, int N, int G_, int c_) { init(cnt, N, G_, c_); so.init(main_tiles(ts[8], N / BM, G_) * BM, N, G_, c_); }
    __device__ int expert_of(int pm) const { int e = 0;
#pragma unroll
        for (int k = 1; k < 8; ++k) e = (pm >= ts[k]) ? k : e;
        return __builtin_amdgcn_readfirstlane(e); }
    __device__ bool next(int i, Unit& u) const {
        if (!so.next(i, u)) return false;
        int e = 0;
#pragma unroll
        for (int k = 1; k < 8; ++k) e = (u.pm >= ts[k]) ? k : e;
        u.e = __builtin_amdgcn_readfirstlane(e); return true;
    }
};

struct SingleOrder { Unit u; bool has; __device__ bool next(int i, Unit& o) const { if (i == 0 && has) { o = u; return true; } return false; } };
typedef float f32x2 __attribute__((ext_vector_type(2)));

template <class Epi, class Sched, bool ALIGN_EPI = false, bool SP2 = false, int FP8SC = 0, bool C0 = true>
__device__ __forceinline__ void gemm_phase(PG8_LAS unsigned char* lds, const Gemm g, const Sched& S, const Epi& E, const int wid_  ) {
    int wid = wid_; asm volatile("" : "+s"(wid));
    const int lane = lane_fresh(), tid = wid * 64 + lane, wr = wid >> 2, wc = wid & 3, fr = lane & 15, fq = lane >> 4;
    const int K = g.K, nt = K / BK, KP = g.KP ? g.KP : K;
    unsigned voffA[2], voffB[2];
#pragma unroll
    for (int i = 0; i < 2; ++i) { int R, C; stage_rc(tid * 16 + i * 8192, R, C); const int Rb = Epi::PERM ? ((R & ~31) + perm32(R & 31)) : R;
        voffA[i] = (unsigned)(R * KP + C) * 2u; voffB[i] = (unsigned)(Rb * KP + C) * 2u; }
    const size_t kstep = (size_t)(BK * 2);
    const size_t hstep = (size_t)HALF * KP * 2;
    const size_t tstep = 2 * hstep;
    const unsigned ldsw = (unsigned)wid * 1024u;
    const int aoff = lds_byte(wr * 64 + fr, fq * 8), boff = lds_byte(wc * 32 + fr, fq * 8);
#define PG8_SA(b, h) (((b) * 2 + (h)) * HTB)
#define PG8_SB(b, h) ((4 + (b) * 2 + (h)) * HTB)
#define PG8_STAGE(bufoff, gbase, voff) do { _Pragma("unroll") for (int _i = 0; _i < 2; ++_i) { unsigned _vo = (voff)[_i]; asm volatile("" : "+v"(_vo));   \
        __builtin_amdgcn_global_load_lds((const unsigned*)((const char*)(gbase) + _vo), (PG8_LAS unsigned*)(lds + (bufoff) + ldsw + _i * 8192), 16, 0, 0); } } while (0)
#define PG8_LDA(dst, b, h) do { _Pragma("unroll") for (int m = 0; m < 4; ++m) _Pragma("unroll") for (int k = 0; k < 2; ++k) dst[m][k] = *(const PG8_LAS bf16x8*)(lds + PG8_SA(b, h) + aoff + m * 2048 + k * 1024); } while (0)
#define PG8_LDB(dst, b, h) do { _Pragma("unroll") for (int n = 0; n < 2; ++n) _Pragma("unroll") for (int k = 0; k < 2; ++k) dst[n][k] = *(const PG8_LAS bf16x8*)(lds + PG8_SB(b, h) + boff + n * 2048 + k * 1024); } while (0)
#define PG8_MMA_(ai, bj, At, Bt, FIRST) do { __builtin_amdgcn_s_setprio(1); _Pragma("unroll") for (int m = 0; m < 4; ++m) _Pragma("unroll") for (int n = 0; n < 2; ++n) { \
        if constexpr (FP8SC != 0) { typedef int v4i_ __attribute__((ext_vector_type(4))); typedef int v8i_ __attribute__((ext_vector_type(8))); \
            const v4i_ w0 = __builtin_bit_cast(v4i_, Bt[n][0]), w1 = __builtin_bit_cast(v4i_, Bt[n][1]), x0 = __builtin_bit_cast(v4i_, At[m][0]), x1 = __builtin_bit_cast(v4i_, At[m][1]); \
            acc[ai][bj][m][n] = __builtin_amdgcn_mfma_scale_f32_16x16x128_f8f6f4((v8i_){w0.x, w0.y, w0.z, w0.w, w1.x, w1.y, w1.z, w1.w}, (v8i_){x0.x, x0.y, x0.z, x0.w, x1.x, x1.y, x1.z, x1.w}, (FIRST) ? (f32x4){0.f, 0.f, 0.f, 0.f} : acc[ai][bj][m][n], 0, 0, 0, 0, 0, 0); } \
        else { acc[ai][bj][m][n] = __builtin_amdgcn_mfma_f32_16x16x32_bf16(Bt[n][0], At[m][0], (FIRST) ? (f32x4){0.f, 0.f, 0.f, 0.f} : acc[ai][bj][m][n], 0, 0, 0); \
               acc[ai][bj][m][n] = __builtin_amdgcn_mfma_f32_16x16x32_bf16(Bt[n][1], At[m][1], acc[ai][bj][m][n], 0, 0, 0); } } \
        __builtin_amdgcn_s_setprio(0); } while (0)
#define PG8_MMA(ai, bj, At, Bt) PG8_MMA_(ai, bj, At, Bt, false)
#define PG8_MMA1(ai, bj, At, Bt) do { if (C0 && t == 0) PG8_MMA_(ai, bj, At, Bt, true); else PG8_MMA_(ai, bj, At, Bt, false); } while (0)
#define PG8_WAIT_V(n) asm volatile("s_waitcnt vmcnt(" #n ")" ::: "memory")
#define PG8_WAIT_L(n) asm volatile("s_waitcnt lgkmcnt(" #n ")" ::: "memory")
#define PG8_BAR __builtin_amdgcn_s_barrier()
#define PG8_SCHED __builtin_amdgcn_sched_barrier(0)
    Unit cur, nxt; int ui = 0;
    if (!S.next(0, cur)) return;
    f32x4 acc[2][2][4][2];
    if constexpr (!C0) {
#pragma unroll
        for (int a = 0; a < 2; ++a)
#pragma unroll
            for (int b = 0; b < 2; ++b)
#pragma unroll
                for (int m = 0; m < 4; ++m)
#pragma unroll
                    for (int n = 0; n < 2; ++n) acc[a][b][m][n] = (f32x4){0.f, 0.f, 0.f, 0.f}; }
    bf16x8 At[4][2], B0[2][2], B1[2][2];
    const char* cA = (const char*)g.A + (size_t)cur.pm * tstep; const char* cB = (const char*)g.Bt + (size_t)cur.e * g.bgs + (size_t)cur.pn * tstep;
    if constexpr (SP2) {
        PG8_STAGE(PG8_SB(0, 0), cB, voffB); PG8_STAGE(PG8_SB(0, 1), cB + hstep, voffB); PG8_STAGE(PG8_SA(0, 0), cA, voffA); PG8_STAGE(PG8_SA(0, 1), cA + hstep, voffA);
        if (wr == 1) PG8_BAR;
        PG8_WAIT_V(2); PG8_BAR;
        PG8_STAGE(PG8_SB(1, 0), cB + kstep, voffB); PG8_STAGE(PG8_SA(1, 0), cA + kstep, voffA); PG8_STAGE(PG8_SB(1, 1), cB + hstep + kstep, voffB);
        PG8_WAIT_V(6); PG8_BAR;
    } else {
        PG8_STAGE(PG8_SB(0, 0), cB, voffB); PG8_STAGE(PG8_SA(0, 0), cA, voffA); PG8_STAGE(PG8_SB(0, 1), cB + hstep, voffB); PG8_STAGE(PG8_SA(0, 1), cA + hstep, voffA);
        if (wr == 1) PG8_BAR;
        PG8_WAIT_V(4); PG8_BAR;
        PG8_STAGE(PG8_SB(1, 0), cB + kstep, voffB); PG8_STAGE(PG8_SA(1, 0), cA + kstep, voffA); PG8_STAGE(PG8_SB(1, 1), cB + hstep + kstep, voffB);
        PG8_WAIT_V(6); PG8_BAR;
    }
    for (;;) {
        const bool has_next = S.next(ui + 1, nxt);
        const char* nA = has_next ? (const char*)g.A + (size_t)nxt.pm * tstep : cA; const char* nB = has_next ? (const char*)g.Bt + (size_t)nxt.e * g.bgs + (size_t)nxt.pn * tstep : cB;
        for (int t = 0; t < nt; t += 2) {
            if constexpr (Epi::KHOOK) { if (t == 8 || t == 16) E.khook(acc, cur, t >> 3, wr, wc); }
            const bool last = (t == nt - 2);
            const char* a1 = cA + (size_t)(t + 1) * kstep;
            const char* a2 = last ? nA : cA + (size_t)(t + 2) * kstep; const char* b2 = last ? nB : cB + (size_t)(t + 2) * kstep;
            const char* a3 = a2 + kstep; const char* b3 = b2 + kstep;
            if constexpr (SP2) {
            PG8_LDB(B0, 0, 0); PG8_LDB(B1, 0, 1); PG8_SCHED; PG8_LDA(At, 0, 0); PG8_STAGE(PG8_SA(1, 1), a1 + hstep, voffA);
            PG8_WAIT_V(8); PG8_WAIT_L(0); PG8_BAR; PG8_MMA1(0, 0, At, B0); PG8_MMA1(0, 1, At, B1); PG8_BAR; PG8_SCHED;
            PG8_LDA(At, 0, 1); PG8_STAGE(PG8_SB(0, 0), b2, voffB); PG8_STAGE(PG8_SB(0, 1), b2 + hstep, voffB); PG8_STAGE(PG8_SA(0, 0), a2, voffA);
            PG8_WAIT_V(8); PG8_WAIT_L(0); PG8_BAR; PG8_MMA1(1, 0, At, B0); PG8_MMA1(1, 1, At, B1); PG8_BAR; PG8_SCHED;
            PG8_LDB(B0, 1, 0); PG8_LDB(B1, 1, 1); PG8_SCHED; PG8_LDA(At, 1, 0); PG8_STAGE(PG8_SA(0, 1), a2 + hstep, voffA);
            PG8_WAIT_V(8); PG8_WAIT_L(0); PG8_BAR; PG8_MMA(0, 0, At, B0); PG8_MMA(0, 1, At, B1); PG8_BAR; PG8_SCHED;
            PG8_LDA(At, 1, 1); PG8_STAGE(PG8_SB(1, 0), b3, voffB); PG8_STAGE(PG8_SB(1, 1), b3 + hstep, voffB); PG8_STAGE(PG8_SA(1, 0), a3, voffA);
            PG8_WAIT_V(8); PG8_WAIT_L(0); PG8_BAR; PG8_MMA(1, 0, At, B0); PG8_MMA(1, 1, At, B1); PG8_BAR; PG8_SCHED;
            } else {
            PG8_LDB(B0, 0, 0); PG8_SCHED; PG8_LDA(At, 0, 0); PG8_STAGE(PG8_SA(1, 1), a1 + hstep, voffA);
            PG8_WAIT_L(8); PG8_BAR; PG8_WAIT_L(0); PG8_MMA1(0, 0, At, B0); PG8_BAR; PG8_SCHED;
            PG8_LDB(B1, 0, 1); PG8_STAGE(PG8_SB(0, 0), b2, voffB);
            PG8_BAR; PG8_WAIT_L(0); PG8_MMA1(0, 1, At, B1); PG8_BAR;
            PG8_LDA(At, 0, 1); PG8_STAGE(PG8_SA(0, 0), a2, voffA);
            PG8_BAR; PG8_WAIT_L(0); PG8_MMA1(1, 0, At, B0); PG8_BAR; PG8_SCHED;
            PG8_STAGE(PG8_SB(0, 1), b2 + hstep, voffB);
            PG8_WAIT_V(6); PG8_BAR; PG8_MMA1(1, 1, At, B1); PG8_BAR;
            PG8_LDB(B0, 1, 0); PG8_SCHED; PG8_LDA(At, 1, 0); PG8_STAGE(PG8_SA(0, 1), a2 + hstep, voffA);
            PG8_WAIT_L(8); PG8_BAR; PG8_WAIT_L(0); PG8_MMA(0, 0, At, B0); PG8_BAR; PG8_SCHED;
            PG8_LDB(B1, 1, 1); PG8_STAGE(PG8_SB(1, 0), b3, voffB);
            PG8_BAR; PG8_WAIT_L(0); PG8_MMA(0, 1, At, B1); PG8_BAR;
            PG8_LDA(At, 1, 1); PG8_STAGE(PG8_SA(1, 0), a3, voffA);
            PG8_BAR; PG8_WAIT_L(0); PG8_MMA(1, 0, At, B0); PG8_BAR; PG8_SCHED;
            PG8_STAGE(PG8_SB(1, 1), b3 + hstep, voffB);
            PG8_WAIT_V(6); PG8_BAR; PG8_MMA(1, 1, At, B1); PG8_BAR;
            }
        }
        if constexpr (ALIGN_EPI) { if (wr == 0) PG8_BAR; }
        E(acc, cur, wr, wc);
        if (!has_next) break;
        if constexpr (!C0) {
#pragma unroll
            for (int a = 0; a < 2; ++a)
#pragma unroll
                for (int b = 0; b < 2; ++b)
#pragma unroll
                    for (int m = 0; m < 4; ++m)
#pragma unroll
                        for (int n = 0; n < 2; ++n) acc[a][b][m][n] = (f32x4){0.f, 0.f, 0.f, 0.f}; }
        cur = nxt; cA = nA; cB = nB; ++ui;
        if constexpr (ALIGN_EPI) { if (wr == 1) PG8_BAR; }
    }
    PG8_WAIT_V(0);
    if constexpr (!ALIGN_EPI) { if (wr == 0) PG8_BAR; }
    PG8_BAR;
#undef PG8_SA
#undef PG8_SB
#undef PG8_STAGE
#undef PG8_LDA
#undef PG8_LDB
#undef PG8_MMA
#undef PG8_MMA1
#undef PG8_MMA_
#undef PG8_WAIT_V
#undef PG8_WAIT_L
#undef PG8_BAR
#undef PG8_SCHED
}
}

constexpr float ACT_SCALE = 4.f;
namespace epi {
using pg8::Unit; using pg8::BM; using pg8::HALF;
typedef float f32x4 __attribute__((ext_vector_type(4)));
typedef unsigned u32x4 __attribute__((ext_vector_type(4)));
#define EPI_FOR_ALL(ai, m, bj) _Pragma("unroll") for (int ai = 0; ai < 2; ++ai) _Pragma("unroll") for (int m = 0; m < 4; ++m) _Pragma("unroll") for (int bj = 0; bj < 2; ++bj)

typedef float f32x2 __attribute__((ext_vector_type(2)));
__device__ __forceinline__ f32x2 lo2(f32x4 v) { return __builtin_shufflevector(v, v, 0, 1); }
__device__ __forceinline__ f32x2 hi2(f32x4 v) { return __builtin_shufflevector(v, v, 2, 3); }
__device__ __forceinline__ f32x2 ex2_2(f32x2 x) { return (f32x2){ex2(x.x), ex2(x.y)}; }
__device__ __forceinline__ f32x2 rcp_2(f32x2 x) { return (f32x2){rcpf_(x.x), rcpf_(x.y)}; }
__device__ __forceinline__ u32x4 pack8(f32x4 v0, f32x4 v1) { u32x4 w; w.x = cvt_pk_bf16(v0[0], v0[1]); w.y = cvt_pk_bf16(v0[2], v0[3]); w.z = cvt_pk_bf16(v1[0], v1[1]); w.w = cvt_pk_bf16(v1[2], v1[3]); return w; }

struct EpiInProj {
    static constexpr bool PERM = true, KHOOK = false;
    bf16 *sbq, *sbk, *sbv, *gq, *gk, *gv, *gr, *caq, *gates; float* loga; const float* ga_b; float sc;
    __device__ __forceinline__ void operator()(const f32x4 (&acc)[2][2][4][2], const Unit& u, int wr, int wc) const {
        const int lane_ = lane_fresh(), fr = lane_ & 15, fq = lane_ >> 4;
        const int pn = u.pn; const int row0 = u.pm * BM + wr * 64 + fr; const int cw = wc * 32 + 8 * fq;
        bf16* base; int ldc, colt, act = 0;
        if (pn < 2) { base = sbq; ldc = 512; colt = pn * 256; }
        else if (pn < 4) { base = sbk; ldc = 512; colt = (pn - 2) * 256; }
        else if (pn < 6) { base = sbv; ldc = 512; colt = (pn - 4) * 256; }
        else if (pn == 6) { base = gq; ldc = 256; colt = 0; }
        else if (pn == 7) { base = gk; ldc = 256; colt = 0; }
        else if (pn < 10) { base = gv; ldc = 512; colt = (pn - 8) * 256; }
        else if (pn == 10) { base = nullptr; ldc = 256; colt = 0; act = 3; }
        else if (pn < 13) { base = gr; ldc = 512; colt = (pn - 11) * 256; act = 2; }
        else if (pn < 15) { base = caq; ldc = 512; colt = (pn - 13) * 256; }
        else { base = gates; ldc = 3072; colt = (pn - 15) * 256; act = 1; }
        if (act == 3) {
            EPI_FOR_ALL(ai, m, bj) { const int row = row0 + ai * HALF + m * 16, col = cw + bj * HALF;
                f32x4 b0 = *(const GAS f32x4*)(ga_b + col), b1 = *(const GAS f32x4*)(ga_b + col + 4), o0, o1;
#pragma unroll
                for (int j = 0; j < 4; ++j) { float x = acc[ai][bj][m][0][j] * sc + b0[j]; float y = acc[ai][bj][m][1][j] * sc + b1[j];
                    o0[j] = -(fmaxf(-x, 0.f) + lg2(1.f + ex2(-fabsf(x) * LOG2E)) * 0.6931471805599453f) * 0.0625f;
                    o1[j] = -(fmaxf(-y, 0.f) + lg2(1.f + ex2(-fabsf(y) * LOG2E)) * 0.6931471805599453f) * 0.0625f; }
                float* p = loga + (size_t)row * 256 + col; *(f32x4*)p = o0; *(GAS f32x4*)(p + 4) = o1; }
            return;
        }
        EPI_FOR_ALL(ai, m, bj) { const int row = row0 + ai * HALF + m * 16, col = colt + cw + bj * HALF;
            f32x4 v0 = acc[ai][bj][m][0] * sc, v1 = acc[ai][bj][m][1] * sc;
            if (act == 1) {
#pragma unroll
                for (int j = 0; j < 4; ++j) { v0[j] = sigmoidf_(v0[j]); v1[j] = sigmoidf_(v1[j]); } }
            else if (act == 2) {
#pragma unroll
                for (int j = 0; j < 4; ++j) { v0[j] = v0[j] * sigmoidf_(v0[j]); v1[j] = v1[j] * sigmoidf_(v1[j]); } }
            *(GAS u32x4*)(base + (size_t)row * ldc + col) = pack8(v0, v1); }
    }
};

struct EpiGates {
    static constexpr bool PERM = true, KHOOK = false;
    bf16* gates; float sc;
    __device__ __forceinline__ void operator()(const f32x4 (&acc)[2][2][4][2], const Unit& u, int wr, int wc) const {
        const int lane_ = lane_fresh(), fr = lane_ & 15, fq = lane_ >> 4;
        const int row0 = u.pm * BM + wr * 64 + fr; const int c0 = u.pn * BM + wc * 32 + 8 * fq; const float nsc = -sc * LOG2E;
        EPI_FOR_ALL(ai, m, bj) { f32x2 r[4];
#pragma unroll
            for (int q = 0; q < 4; ++q) { const f32x2 a = (q & 1) ? hi2(acc[ai][bj][m][q >> 1]) : lo2(acc[ai][bj][m][q >> 1]); r[q] = a * nsc; }
            __builtin_amdgcn_sched_barrier(0);
#pragma unroll
            for (int q = 0; q < 4; ++q) r[q] = ex2_2(r[q]);
            __builtin_amdgcn_sched_barrier(0);
#pragma unroll
            for (int q = 0; q < 4; ++q) r[q] = r[q] + 1.f;
            __builtin_amdgcn_sched_barrier(0);
#pragma unroll
            for (int q = 0; q < 4; ++q) r[q] = rcp_2(r[q]);
            __builtin_amdgcn_sched_barrier(0);
            u32x4 w; w.x = cvt_pk_bf16(r[0].x, r[0].y); w.y = cvt_pk_bf16(r[1].x, r[1].y); w.z = cvt_pk_bf16(r[2].x, r[2].y); w.w = cvt_pk_bf16(r[3].x, r[3].y);
            *(GAS u32x4*)(gates + (size_t)(row0 + ai * HALF + m * 16) * 3072 + c0 + bj * HALF) = w; }
    }
};

struct EpiBf16Split {
    static constexpr bool PERM = true, KHOOK = false;
    bf16 *O0, *O1; int ldc, nsplit; float sc;
    __device__ __forceinline__ void operator()(const f32x4 (&acc)[2][2][4][2], const Unit& u, int wr, int wc) const {
        const int lane_ = lane_fresh(), fr = lane_ & 15, fq = lane_ >> 4;
        const int row0 = u.pm * BM + wr * 64 + fr; const int cw = wc * 32 + 8 * fq;
        bf16* base = (u.pn < nsplit) ? O0 : O1; const int colt = ((u.pn < nsplit) ? u.pn : u.pn - nsplit) * 256;
        EPI_FOR_ALL(ai, m, bj) { const int row = row0 + ai * HALF + m * 16, col = colt + cw + bj * HALF;
            *(GAS u32x4*)(base + (size_t)row * ldc + col) = pack8(acc[ai][bj][m][0] * sc, acc[ai][bj][m][1] * sc); }
    }
};

struct EpiBranch {
    static constexpr bool PERM = true, KHOOK = true;
    const bf16* gates; bf16* O;
    __device__ __forceinline__ void khook(f32x4 (&acc)[2][2][4][2], const Unit& u, int s, int wr, int wc) const {
        const int lane_ = lane_fresh(), fr = lane_ & 15, fq = lane_ >> 4;
        int row0 = u.pm * BM + wr * 64 + fr; int c0 = u.pn * BM + wc * 32 + 8 * fq;
        asm volatile("" : "+v"(row0), "+v"(c0));
#pragma unroll
        for (int ai = 0; ai < 2; ++ai)
#pragma unroll
            for (int mh = 0; mh < 2; ++mh) {
                u32x4 gn[2][2], gd[2][2];
#pragma unroll
                for (int mm = 0; mm < 2; ++mm)
#pragma unroll
                    for (int bj = 0; bj < 2; ++bj) { const bf16* gp = gates + (size_t)(row0 + ai * HALF + (2 * mh + mm) * 16) * 3072 + c0 + bj * HALF;
                        gn[mm][bj] = *(const GAS u32x4*)(gp + (size_t)(s - 1) * 1024); gd[mm][bj] = *(const GAS u32x4*)(gp + (size_t)s * 1024); }
#pragma unroll
                for (int mm = 0; mm < 2; ++mm)
#pragma unroll
                    for (int bj = 0; bj < 2; ++bj) { const int m = 2 * mh + mm;
#pragma unroll
                        for (int j = 0; j < 4; ++j) { const unsigned n_ = gn[mm][bj][j], d_ = gd[mm][bj][j];
                            const float r0 = bflo(n_) * rcpf_(fmaxf(bflo(d_), 1e-30f)), r1 = bfhi(n_) * rcpf_(fmaxf(bfhi(d_), 1e-30f));
                            if (j < 2) { acc[ai][bj][m][0][2 * j] *= r0; acc[ai][bj][m][0][2 * j + 1] *= r1; }
                            else { acc[ai][bj][m][1][2 * (j - 2)] *= r0; acc[ai][bj][m][1][2 * (j - 2) + 1] *= r1; } } }
                asm volatile("" ::: "memory");
            }
    }
    __device__ __forceinline__ void operator()(const f32x4 (&acc)[2][2][4][2], const Unit& u, int wr, int wc) const {
        const int lane_ = lane_fresh(), fr = lane_ & 15, fq = lane_ >> 4;
        const int row0 = u.pm * BM + wr * 64 + fr; const int c0 = u.pn * BM + wc * 32 + 8 * fq;
        EPI_FOR_ALL(ai, m, bj) { const int row = row0 + ai * HALF + m * 16, col = c0 + bj * HALF;
            const u32x4 g2 = *(const GAS u32x4*)(gates + (size_t)row * 3072 + 2048 + col);
            f32x4 v0 = acc[ai][bj][m][0], v1 = acc[ai][bj][m][1];
            v0[0] *= fmaxf(bflo(g2[0]), 1e-30f); v0[1] *= fmaxf(bfhi(g2[0]), 1e-30f); v0[2] *= fmaxf(bflo(g2[1]), 1e-30f); v0[3] *= fmaxf(bfhi(g2[1]), 1e-30f);
            v1[0] *= fmaxf(bflo(g2[2]), 1e-30f); v1[1] *= fmaxf(bfhi(g2[2]), 1e-30f); v1[2] *= fmaxf(bflo(g2[3]), 1e-30f); v1[3] *= fmaxf(bfhi(g2[3]), 1e-30f);
            *(GAS u32x4*)(O + (size_t)row * 1024 + col) = pack8(v0, v1); }
    }
};

struct EpiResF32 {
    static constexpr bool PERM = true, KHOOK = false;
    const float* res; float* out; float sc;
    __device__ __forceinline__ void operator()(const f32x4 (&acc)[2][2][4][2], const Unit& u, int wr, int wc) const {
        const int lane_ = lane_fresh(), fr = lane_ & 15, fq = lane_ >> 4;
        const int row0 = u.pm * BM + wr * 64 + fr; const int c0 = u.pn * BM + wc * 32 + 8 * fq;
        EPI_FOR_ALL(ai, m, bj) { const size_t off = (size_t)(row0 + ai * HALF + m * 16) * 1024 + c0 + bj * HALF;
            const f32x4 r0 = *(const GAS f32x4*)(res + off), r1 = *(const GAS f32x4*)(res + off + 4);
            *(GAS f32x4*)(out + off) = r0 + acc[ai][bj][m][0] * sc; *(GAS f32x4*)(out + off + 4) = r1 + acc[ai][bj][m][1] * sc; }
    }
};

template <bool OUT_FP8> struct EpiSwiGLU {
    static constexpr bool PERM = true, KHOOK = false;
    unsigned char* O; int ldc; float sc;
    __device__ __forceinline__ void operator()(const f32x4 (&acc)[2][2][4][2], const Unit& u, int wr, int wc) const {
        const int lane_ = lane_fresh(), fr = lane_ & 15, fq = lane_ >> 4;
        const int row0 = u.pm * BM + wr * 64 + fr; const int c0 = u.pn * HALF + wc * 32 + 8 * fq; const float s2 = OUT_FP8 ? sc * ACT_SCALE : sc; const float c1 = -sc * LOG2E, c2 = sc * s2;
#pragma unroll
        for (int ai = 0; ai < 2; ++ai)
#pragma unroll
            for (int m = 0; m < 4; ++m) { f32x2 v[4];
#pragma unroll
                for (int q = 0; q < 4; ++q) { const f32x2 g = (q & 1) ? hi2(acc[ai][0][m][q >> 1]) : lo2(acc[ai][0][m][q >> 1]); v[q] = g * c1; }
                __builtin_amdgcn_sched_barrier(0);
#pragma unroll
                for (int q = 0; q < 4; ++q) v[q] = ex2_2(v[q]);
                __builtin_amdgcn_sched_barrier(0);
#pragma unroll
                for (int q = 0; q < 4; ++q) v[q] = v[q] + 1.f;
                __builtin_amdgcn_sched_barrier(0);
#pragma unroll
                for (int q = 0; q < 4; ++q) v[q] = rcp_2(v[q]);
                __builtin_amdgcn_sched_barrier(0);
#pragma unroll
                for (int q = 0; q < 4; ++q) { const f32x2 g = (q & 1) ? hi2(acc[ai][0][m][q >> 1]) : lo2(acc[ai][0][m][q >> 1]), u = (q & 1) ? hi2(acc[ai][1][m][q >> 1]) : lo2(acc[ai][1][m][q >> 1]);
                    v[q] = (g * v[q]) * (u * c2); }
                if constexpr (OUT_FP8) { v2u w; w.x = pk4_fp8(v[0].x, v[0].y, v[1].x, v[1].y); w.y = pk4_fp8(v[2].x, v[2].y, v[3].x, v[3].y);
                    *(GAS v2u*)(O + (size_t)(row0 + ai * HALF + m * 16) * ldc + c0) = w; }
                else { u32x4 w; w.x = cvt_pk_bf16(v[0].x, v[0].y); w.y = cvt_pk_bf16(v[1].x, v[1].y); w.z = cvt_pk_bf16(v[2].x, v[2].y); w.w = cvt_pk_bf16(v[3].x, v[3].y);
                    *(GAS u32x4*)((bf16*)O + (size_t)(row0 + ai * HALF + m * 16) * ldc + c0) = w; } }
    }
};
}

#define XB_TMO      128
#define XB_XCNT(j)  (256  + 64 * (j))
#define XB_XSUB(j)  (1280 + 64 * (j))
#define XB_XGEN(j)  (2304 + 64 * (j))
#define XB_TOP      3328
#define XB_TOPGEN   3392
#define XCD_BAR_WORDS 3456
#define XB_SPIN_CAP (1u << 18)
__device__ __forceinline__ unsigned xb_ld(unsigned* p)              { return __hip_atomic_load(p, __ATOMIC_RELAXED, __HIP_MEMORY_SCOPE_AGENT); }
__device__ __forceinline__ unsigned xb_add(unsigned* p, unsigned v) { return __hip_atomic_fetch_add(p, v, __ATOMIC_RELAXED, __HIP_MEMORY_SCOPE_AGENT); }
__device__ __forceinline__ unsigned xb_xcc_id() { return (unsigned)__builtin_amdgcn_s_getreg((3 << 11) | 20) & 0xFu; }
#define XB_SPIN(cond, bar) do { unsigned _sp = 0; while (cond) { __builtin_amdgcn_s_sleep(1); \
    if ((++_sp & 255u) == 0u) { if (xb_ld(&(bar)[XB_TMO])) break; if (_sp > XB_SPIN_CAP) { atomicAdd(&(bar)[XB_TMO], 1u); break; } } } } while (0)
struct XcdBarrier { unsigned* bar; unsigned x; volatile LAS unsigned* st; };
__device__ __forceinline__ XcdBarrier xcd_barrier_post(unsigned* bar, volatile LAS unsigned* st) {
    XcdBarrier b; b.bar = bar; b.x = xb_xcc_id(); b.st = st;
    if (threadIdx.x == 0) (void)xb_add(&bar[XB_XCNT(b.x)], 1u);
    return b;
}
__device__ __forceinline__ void xcd_barrier_complete(unsigned* bar, unsigned x, unsigned& nloc, unsigned& nx) {
    const unsigned G = gridDim.x * gridDim.y * gridDim.z;
    unsigned sum, cnt, mine, sp = 0u;
    for (;;) {
        sum = 0u; cnt = 0u; mine = 0u;
#pragma unroll
        for (unsigned j = 0; j < 16; ++j) { const unsigned c = xb_ld(&bar[XB_XCNT(j)]); sum += c; cnt += (c > 0u) ? 1u : 0u; mine = (j == x) ? c : mine; }
        if (sum == G) break;
        __builtin_amdgcn_s_sleep(1);
        if ((++sp & 255u) == 0u) { if (xb_ld(&bar[XB_TMO])) break; if (sp > XB_SPIN_CAP) { atomicAdd(&bar[XB_TMO], 1u); break; } }
    }
    nloc = mine > 0u ? mine : 1u; nx = cnt > 0u ? cnt : 1u;
}
__device__ __forceinline__ void xcd_barrier(const XcdBarrier& b, const bool leader  ) {
    asm volatile("s_waitcnt vmcnt(0)" ::: "memory");
    __syncthreads();
    if (leader) {
        unsigned* bar = b.bar; asm volatile("" : "+s"(bar));
        __builtin_amdgcn_s_waitcnt(0);
        unsigned bx = b.x; asm volatile("" : "+s"(bx));
        unsigned nloc = b.st[0], nx = b.st[1];
        if (nloc == 0u) { xcd_barrier_complete(bar, bx, nloc, nx); b.st[0] = nloc; b.st[1] = nx; }
        const unsigned old = xb_add(&bar[XB_XSUB(bx)], 1u);
        const unsigned gen = old / nloc;
        if (old + 1u == (gen + 1u) * nloc) {
            __builtin_amdgcn_fence(__ATOMIC_RELEASE, "agent");
            asm volatile("s_waitcnt vmcnt(0)" ::: "memory");
            const unsigned og = xb_add(&bar[XB_TOP], 1u);
            const unsigned tg = og / nx;
            if (og + 1u == (tg + 1u) * nx) xb_add(&bar[XB_TOPGEN], 1u);
            else XB_SPIN(xb_ld(&bar[XB_TOPGEN]) == tg, bar);
            __builtin_amdgcn_fence(__ATOMIC_ACQUIRE, "agent");
            xb_add(&bar[XB_XGEN(bx)], 1u);
            asm volatile("s_waitcnt vmcnt(0)" ::: "memory");
        } else {
            XB_SPIN(xb_ld(&bar[XB_XGEN(bx)]) == gen, bar);
            __builtin_amdgcn_fence(__ATOMIC_ACQUIRE, "agent");
            asm volatile("s_waitcnt vmcnt(0)" ::: "memory");
        }
    }
    __syncthreads();
}

struct Frame {
    LAS unsigned char* lds;
    int wave, vcu, G;
    unsigned char* ws; const float* const* in; float* out;
};
template <class T> __device__ __forceinline__ T* wsp(const Frame& F, size_t off) { return (T*)(F.ws + off); }

enum { I_X = 0, I_MEM, I_MIXG, I_WIN, I_SBQG, I_SBKG, I_GAUP, I_GAB, I_GOG, I_CAQG, I_CAKG, I_MEMG, I_WMKV, I_WBRSB, I_WBRGLA, I_WBRCA, I_WOUT, I_FFNG,
       I_FFGU, I_FFDN, I_ROUTER, I_MOEGU, I_MOEDN, N_IN };

__device__ __forceinline__ void tr_store(bf16* dst, int dp, LAS float* scr, int lane) {
    LDS_WAIT(); asm volatile("" ::: "memory");
    const int c = lane & 7;
#pragma unroll
    for (int j = 0; j < 4; ++j) { const int n = (lane >> 3) + 8 * j; const LAS float* s = scr + (8 * c) * 33 + n;
        v4u o; o.x = pk2(s[0 * 33], s[1 * 33]); o.y = pk2(s[2 * 33], s[3 * 33]); o.z = pk2(s[4 * 33], s[5 * 33]); o.w = pk2(s[6 * 33], s[7 * 33]);
        *(GAS v4u*)(dst + (size_t)n * dp + 8 * c) = o; }
    LDS_WAIT(); asm volatile("" ::: "memory");
}
__device__ __forceinline__ void tr_item(const float* src, int sp, bf16* dst, int dp, LAS float* scr, int lane) {
#pragma unroll 8
    for (int i = 0; i < 32; ++i) { const int kk = 2 * i + (lane >> 5); scr[kk * 33 + (lane & 31)] = src[(size_t)kk * sp + (lane & 31)]; }
    tr_store(dst, dp, scr, lane);
}
__device__ __forceinline__ void tr_item_fp8(const float* src, int sp, unsigned char* dst, int dp, float scale, LAS float* scr, int lane) {
#pragma unroll 8
    for (int i = 0; i < 32; ++i) { const int kk = 2 * i + (lane >> 5); scr[kk * 33 + (lane & 31)] = src[(size_t)kk * sp + (lane & 31)] * scale; }
    LDS_WAIT(); asm volatile("" ::: "memory");
    const int c = lane & 7;
#pragma unroll
    for (int j = 0; j < 4; ++j) { const int n = (lane >> 3) + 8 * j; const LAS float* s = scr + (8 * c) * 33 + n;
        v2u o; o.x = pk4_fp8(s[0 * 33], s[1 * 33], s[2 * 33], s[3 * 33]); o.y = pk4_fp8(s[4 * 33], s[5 * 33], s[6 * 33], s[7 * 33]);
        *(GAS v2u*)(dst + (size_t)n * dp + 8 * c) = o; }
    LDS_WAIT(); asm volatile("" ::: "memory");
}
template <bool FP8> __device__ __forceinline__ void tr_item_ga(const float* win_k0  , const float* up_n0  , bf16* dst, int dp, LAS float* scr, int lane) {
    float u[16];
#pragma unroll
    for (int r = 0; r < 16; ++r) u[r] = up_n0[r * 256 + (lane & 31)];
#pragma unroll 4
    for (int i = 0; i < 32; ++i) { const int kk = 2 * i + (lane >> 5); const float* w = win_k0 + (size_t)kk * IN_W; float s = 0.f;
#pragma unroll
        for (int r = 0; r < 16; ++r) s += w[r] * u[r];
        scr[kk * 33 + (lane & 31)] = FP8 ? s * 32.f : s; }
    if constexpr (FP8) {
        LDS_WAIT(); asm volatile("" ::: "memory");
        const int c = lane & 7; unsigned char* d8 = (unsigned char*)dst;
#pragma unroll
        for (int j = 0; j < 4; ++j) { const int n = (lane >> 3) + 8 * j; const LAS float* s_ = scr + (8 * c) * 33 + n;
            v2u o; o.x = pk4_fp8(s_[0 * 33], s_[1 * 33], s_[2 * 33], s_[3 * 33]); o.y = pk4_fp8(s_[4 * 33], s_[5 * 33], s_[6 * 33], s_[7 * 33]);
            *(GAS v2u*)(d8 + (size_t)n * dp + 8 * c) = o; }
        LDS_WAIT(); asm volatile("" ::: "memory");
    } else tr_store(dst, dp, scr, lane);
}

__device__ __forceinline__ void rms_row_to_bf16(const float* xrow, const float* gain, bf16* orow, int lane) {
    const f32x4* xr = (const f32x4*)xrow + lane; const f32x4* gr = (const f32x4*)gain + lane;
    f32x4 v[4]; float s = 0.f;
#pragma unroll
    for (int j = 0; j < 4; ++j) { v[j] = xr[64 * j]; s += (v[j].x * v[j].x + v[j].y * v[j].y) + (v[j].z * v[j].z + v[j].w * v[j].w); }
    const float rstd = 1.f / sqrtf(wave_sum(s, lane >> 5) * (1.f / 1024.f) + EPS);
    unsigned long long* o8 = (unsigned long long*)orow + lane;
#pragma unroll
    for (int j = 0; j < 4; ++j) { const f32x4 g = gr[64 * j];
        o8[64 * j] = (unsigned long long)pk2(v[j].x * rstd * g.x, v[j].y * rstd * g.y) | ((unsigned long long)pk2(v[j].z * rstd * g.z, v[j].w * rstd * g.w) << 32); }
}

template <int OUT> __device__ __forceinline__ void rms_rows(const float* x, int nrows, const float* gain, unsigned char* obase, int gw, int NGW, int lane, unsigned char* obase8 = nullptr);
struct TrItem { const float* src; const float* up; unsigned char* dst; int sp, dp, mode; float scale; };
__device__ __forceinline__ TrItem tr_decode(const Frame& F, int it) {
    constexpr int KB = 1024 / 64;
    constexpr int I_IN = KB * (IN_WP / 32), I_MKV = KB * 32, I_BR = (512 / 64) * 32, I_OUT = KB * 32;
    constexpr int I_GU0 = KB * (2 * DFF / 32), I_DN0 = (DFF / 64) * 32, I_GUE = KB * (2 * DFFE / 32), I_DNE = (DFFE / 64) * 32;
    constexpr int PER_LAYER = I_IN + I_MKV + 3 * I_BR + I_OUT;
    TrItem t; t.up = nullptr; t.mode = 0; t.scale = 1.f; int r = it;
    if (r < 2 * PER_LAYER) {
        const int l = r / PER_LAYER; r -= l * PER_LAYER;
        if (r < I_IN) { const int nb = r % (IN_WP / 32), kb = r / (IN_WP / 32); const int n0 = nb * 32, k0 = kb * 64;
            const float* W = F.in[I_WIN] + (size_t)l * 1024 * IN_W; unsigned char* WT = F.ws + WS_WIN + (size_t)l * IN_WP * 1024 * 2;
            t.sp = IN_W; t.dp = 2048; t.dst = WT + (size_t)n0 * 2048 + k0 * 2;
            if (n0 >= 3840) { t.mode = 1; t.scale = 32.f; t.dp = 1024; t.dst = WT + (size_t)3840 * 2048 + (size_t)(n0 - 3840) * 1024 + k0; }
            if (n0 >= 2560 && n0 < 2816) { t.mode = 2; t.src = W + (size_t)k0 * IN_W + 2560; t.up = F.in[I_GAUP] + (size_t)l * 16 * 256 + (n0 - 2560); }
            else t.src = W + (size_t)k0 * IN_W + ((n0 < 2560) ? n0 : n0 - 240);
            return t; }
        r -= I_IN;
        if (r < I_MKV) { const int nb = r % 32, kb = r / 32; t.src = F.in[I_WMKV] + (size_t)l * 1024 * 1024 + (size_t)kb * 64 * 1024 + nb * 32; t.sp = 1024;
            t.dst = F.ws + WS_WMKV + ((size_t)l * 1024 * 1024 + (size_t)nb * 32 * 1024 + kb * 64) * 2; t.dp = 2048; return t; }
        r -= I_MKV;
        if (r < 3 * I_BR) { const int br = r / I_BR; r -= br * I_BR; const int nb = r % 32, kb = r / 32;
            t.src = F.in[I_WBRSB + br] + (size_t)l * 512 * 1024 + (size_t)kb * 64 * 1024 + nb * 32; t.sp = 1024;
            t.dst = F.ws + WS_WBR + ((size_t)l * 1024 * 1536 + (size_t)nb * 32 * 1536 + br * 512 + kb * 64) * 2; t.dp = 3072; return t; }
        r -= 3 * I_BR;
        { const int nb = r % 32, kb = r / 32; t.src = F.in[I_WOUT] + (size_t)l * 1024 * 1024 + (size_t)kb * 64 * 1024 + nb * 32; t.sp = 1024;
            t.dst = F.ws + WS_WOUT + ((size_t)l * 1024 * 1024 + (size_t)nb * 32 * 1024 + kb * 64) * 2; t.dp = 2048; return t; }
    }
    r -= 2 * PER_LAYER;
    if (r < I_GU0) {
        const int nb = r % (2 * DFF / 32), kb = r / (2 * DFF / 32); const int sc = nb * 32; const bool up = sc >= DFF; const int ch = up ? sc - DFF : sc;
        const int drow = 256 * (ch / 128) + (up ? 128 : 0) + (ch % 128);
        t.src = F.in[I_FFGU] + (size_t)kb * 64 * (2 * DFF) + sc; t.sp = 2 * DFF; t.dst = F.ws + WS_WGU0 + ((size_t)drow * 1024 + kb * 64) * 2; t.dp = 2048; return t; }
    r -= I_GU0;
    if (r < I_DN0) { const int nb = r % 32, kb = r / 32; t.src = F.in[I_FFDN] + (size_t)kb * 64 * 1024 + nb * 32; t.sp = 1024;
        t.dst = F.ws + WS_WDN0 + ((size_t)nb * 32 * DFF + kb * 64) * 2; t.dp = DFF * 2; return t; }
    r -= I_DN0;
    if (r < NEXP * I_GUE) { const int e = r / I_GUE; r -= e * I_GUE;
        const int nb = r % (2 * DFFE / 32), kb = r / (2 * DFFE / 32); const int sc = nb * 32; const bool up = sc >= DFFE; const int ch = up ? sc - DFFE : sc;
        const int drow = 256 * (ch / 128) + (up ? 128 : 0) + (ch % 128);
        t.src = F.in[I_MOEGU] + (size_t)e * 1024 * (2 * DFFE) + (size_t)kb * 64 * (2 * DFFE) + sc; t.sp = 2 * DFFE;
        t.dst = F.ws + WS_WGUE + (size_t)e * (2 * DFFE) * 1024 + (size_t)drow * 1024 + kb * 64; t.dp = 1024; t.mode = 1; t.scale = 32.f; return t; }
    r -= NEXP * I_GUE;
    { const int e = r / I_DNE; r -= e * I_DNE; const int nb = r % 32, kb = r / 32;
        t.src = F.in[I_MOEDN] + (size_t)e * DFFE * 1024 + (size_t)kb * 64 * 1024 + nb * 32; t.sp = 1024;
        t.dst = F.ws + WS_WDNE + (size_t)e * 1024 * DFFE + (size_t)nb * 32 * DFFE + kb * 64; t.dp = DFFE; t.mode = 1; t.scale = 64.f; return t; }
}
__device__ __forceinline__ void tr_load(const TrItem& t, int lane, float (&v)[32]) {
    if (t.mode == 2) {
        float u[16];
#pragma unroll
        for (int r = 0; r < 16; ++r) u[r] = t.up[r * 256 + (lane & 31)];
#pragma unroll 4
        for (int i = 0; i < 32; ++i) { const float* w = t.src + (size_t)(2 * i + (lane >> 5)) * IN_W; float s_ = 0.f;
#pragma unroll
            for (int r = 0; r < 16; ++r) s_ += w[r] * u[r];
            v[i] = s_; }
    } else {
        const float* p_ = t.src + (size_t)(lane >> 5) * t.sp + (lane & 31); const size_t st = (size_t)2 * t.sp;
#pragma unroll
        for (int i = 0; i < 32; ++i) v[i] = p_[i * st];
    }
}
__device__ __forceinline__ void tr_emit(const TrItem& t, int lane, const float (&v)[32], LAS float* scr) {
#pragma unroll
    for (int i = 0; i < 32; ++i) scr[(2 * i + (lane >> 5)) * 33 + (lane & 31)] = v[i] * t.scale;
    LDS_WAIT(); asm volatile("" ::: "memory");
    const int c = lane & 7;
#pragma unroll
    for (int j = 0; j < 4; ++j) { const int n = (lane >> 3) + 8 * j; const LAS float* s_ = scr + (8 * c) * 33 + n;
        if (t.mode == 1) { v2u o; o.x = pk4_fp8(s_[0 * 33], s_[1 * 33], s_[2 * 33], s_[3 * 33]); o.y = pk4_fp8(s_[4 * 33], s_[5 * 33], s_[6 * 33], s_[7 * 33]);
            *(GAS v2u*)(t.dst + (size_t)n * t.dp + 8 * c) = o; }
        else { v4u o; o.x = pk2(s_[0 * 33], s_[1 * 33]); o.y = pk2(s_[2 * 33], s_[3 * 33]); o.z = pk2(s_[4 * 33], s_[5 * 33]); o.w = pk2(s_[6 * 33], s_[7 * 33]);
            *(GAS v4u*)(t.dst + (size_t)n * t.dp + 16 * c) = o; } }
    LDS_WAIT(); asm volatile("" ::: "memory");
}
__device__ __forceinline__ void phase_prologue(const Frame& F) {
    LAS float* scr = (LAS float*)(F.lds + F.wave * 16384);
    const int gw = F.vcu * 8 + F.wave, NGW = F.G * 8, lane = lane_fresh();
    constexpr int KB = 1024 / 64;
    constexpr int NITEMS = 2 * (KB * (IN_WP / 32) + KB * 32 + 3 * (512 / 64) * 32 + KB * 32) + KB * (2 * DFF / 32) + (DFF / 64) * 32 + NEXP * (KB * (2 * DFFE / 32) + (DFFE / 64) * 32);
    float va[32], vb[32];
    int it = gw; TrItem ta, tb;
    if (it < NITEMS) { ta = tr_decode(F, it); tr_load(ta, lane, va); }
    while (it < NITEMS) {
        const int itn = it + NGW; const bool more = itn < NITEMS;
        if (more) { tb = tr_decode(F, itn); tr_load(tb, lane, vb); }
        tr_emit(ta, lane, va, scr);
        if (more) { ta = tb;
#pragma unroll
            for (int i = 0; i < 32; ++i) va[i] = vb[i]; }
        it = itn;
    }
    rms_rows<2>(F.in[I_X], MTOK, F.in[I_MIXG], wsp<unsigned char>(F, WS_HBUF), gw, NGW, lane, wsp<unsigned char>(F, WS_HB8));
    rms_rows<0>(F.in[I_MEM], MMEM, F.in[I_MEMG], wsp<unsigned char>(F, WS_HMEM), gw, NGW, lane);
    rms_rows<0>(F.in[I_MEM], MMEM, F.in[I_MEMG] + 1024, wsp<unsigned char>(F, WS_HMEM) + (size_t)MMEM * 2048, gw, NGW, lane);
}

__device__ __forceinline__ void rms_row_to_fp8(const float* xrow, const float* gain, unsigned char* orow, int lane) {
    const f32x4* xr = (const f32x4*)xrow + lane; const f32x4* gr = (const f32x4*)gain + lane;
    f32x4 v[4]; float s = 0.f;
#pragma unroll
    for (int j = 0; j < 4; ++j) { v[j] = xr[64 * j]; s += (v[j].x * v[j].x + v[j].y * v[j].y) + (v[j].z * v[j].z + v[j].w * v[j].w); }
    const float rstd = 1.f / sqrtf(wave_sum(s, lane >> 5) * (1.f / 1024.f) + EPS);
    unsigned* o4 = (unsigned*)orow + lane;
#pragma unroll
    for (int j = 0; j < 4; ++j) { const f32x4 g = gr[64 * j]; o4[64 * j] = pk4_fp8(v[j].x * rstd * g.x, v[j].y * rstd * g.y, v[j].z * rstd * g.z, v[j].w * rstd * g.w); }
}
__device__ __forceinline__ void phase_rms_fp8(const Frame& F, const float* x, const float* gain) {
    const int gw = F.vcu * 8 + F.wave, NGW = F.G * 8, lane = lane_fresh();
    rms_rows<1>(x, MTOK, gain, wsp<unsigned char>(F, WS_HBUF), gw, NGW, lane);
}
template <int OUT> __device__ __forceinline__ void rms_rows(const float* x, int nrows, const float* gain, unsigned char* obase, int gw, int NGW, int lane, unsigned char* obase8) {
    f32x4 g[4];
#pragma unroll
    for (int j = 0; j < 4; ++j) g[j] = *((const GAS f32x4*)gain + lane + 64 * j);
    for (int m0 = gw; m0 < nrows; m0 += 4 * NGW) {
        f32x4 v[4][4];
#pragma unroll
        for (int k = 0; k < 4; ++k) { const int m = m0 + k * NGW; if (m < nrows) {
#pragma unroll
            for (int j = 0; j < 4; ++j) v[k][j] = *((const GAS f32x4*)(x + (size_t)m * 1024) + lane + 64 * j); } }
#pragma unroll
        for (int k = 0; k < 4; ++k) { const int m = m0 + k * NGW; if (m < nrows) {
            float s_ = 0.f;
#pragma unroll
            for (int j = 0; j < 4; ++j) s_ += (v[k][j].x * v[k][j].x + v[k][j].y * v[k][j].y) + (v[k][j].z * v[k][j].z + v[k][j].w * v[k][j].w);
            const float rstd = 1.f / sqrtf(wave_sum(s_, lane >> 5) * (1.f / 1024.f) + EPS);
#pragma unroll
            for (int j = 0; j < 4; ++j) { const f32x4 y = v[k][j] * rstd * g[j];
                if (OUT == 1) *((GAS unsigned*)(obase + (size_t)m * 1024) + lane + 64 * j) = pk4_fp8(y.x, y.y, y.z, y.w);
                else *((GAS v2u*)(obase + (size_t)m * 2048) + lane + 64 * j) = (v2u){pk2(y.x, y.y), pk2(y.z, y.w)};
                if (OUT == 2) *((GAS unsigned*)(obase8 + (size_t)m * 1024) + lane + 64 * j) = pk4_fp8(y.x, y.y, y.z, y.w); } } }
    }
}
__device__ __forceinline__ void phase_rms(const Frame& F, const float* x, const float* gain, bool dual = false) {
    const int gw = F.vcu * 8 + F.wave, NGW = F.G * 8, lane = lane_fresh();
    if (dual) rms_rows<2>(x, MTOK, gain, wsp<unsigned char>(F, WS_HBUF), gw, NGW, lane, wsp<unsigned char>(F, WS_HB8));
    else rms_rows<0>(x, MTOK, gain, wsp<unsigned char>(F, WS_HBUF), gw, NGW, lane);
}

template <int HD> __device__ __forceinline__ void headnorm_rows(const Frame& F, bf16* buf, int rows, const float* gain, float scale) {
    const int gw = F.vcu * 8 + F.wave, NGW = F.G * 8, lane = lane_fresh();
    const int d0 = (lane * 8) & (HD - 1);
    float g[8];
#pragma unroll
    for (int j = 0; j < 8; ++j) g[j] = gain[d0 + j] * scale;
    for (int m = gw; m < rows; m += NGW) {
        v4u* p = (v4u*)(buf + (size_t)m * 512) + lane; const v4u w = *p; float x[8];
        x[0] = bflo(w.x); x[1] = bfhi(w.x); x[2] = bflo(w.y); x[3] = bfhi(w.y); x[4] = bflo(w.z); x[5] = bfhi(w.z); x[6] = bflo(w.w); x[7] = bfhi(w.w);
        float s = 0.f;
#pragma unroll
        for (int j = 0; j < 8; ++j) s += x[j] * x[j];
        s += swz_xor<1>(s); s += swz_xor<2>(s); s += swz_xor<4>(s); if (HD == 128) s += swz_xor<8>(s);
        const float rstd = 1.f / sqrtf(s * (1.f / HD) + EPS);
        v4u o; o.x = pk2(x[0] * rstd * g[0], x[1] * rstd * g[1]); o.y = pk2(x[2] * rstd * g[2], x[3] * rstd * g[3]); o.z = pk2(x[4] * rstd * g[4], x[5] * rstd * g[5]); o.w = pk2(x[6] * rstd * g[6], x[7] * rstd * g[7]);
        *p = o;
    }
}

__device__ __forceinline__ s16x4 vtr(const LAS unsigned char* p) { typedef short v4i16_t __attribute__((ext_vector_type(4))); return __builtin_bit_cast(s16x4, __builtin_amdgcn_ds_read_tr16_b64_v4i16((LAS v4i16_t*)p)); }
#define MK8(lo, hi) (bf16x8){lo[0], lo[1], lo[2], lo[3], hi[0], hi[1], hi[2], hi[3]}

__device__ __forceinline__ v4u scale8(v4u w, float rstd, const float (&g)[8]) {
    v4u o; o.x = cvt_pk_bf16(bflo(w.x) * rstd * g[0], bfhi(w.x) * rstd * g[1]); o.y = cvt_pk_bf16(bflo(w.y) * rstd * g[2], bfhi(w.y) * rstd * g[3]);
    o.z = cvt_pk_bf16(bflo(w.z) * rstd * g[4], bfhi(w.z) * rstd * g[5]); o.w = cvt_pk_bf16(bflo(w.w) * rstd * g[6], bfhi(w.w) * rstd * g[7]); return o; }
__device__ __forceinline__ float sumsq8(v4u w) { const float a = bflo(w.x), b = bfhi(w.x), c = bflo(w.y), d = bfhi(w.y), e = bflo(w.z), f = bfhi(w.z), g = bflo(w.w), h = bfhi(w.w);
    return ((a * a + b * b) + (c * c + d * d)) + ((e * e + f * f) + (g * g + h * h)); }


template <bool MASK, bool DO_PV> __device__ __forceinline__ void sb2_body(const LAS unsigned char* kbn  , const LAS unsigned char* vbp  ,
        const bf16x8 (&qr)[4], f32x16& pc0, f32x16& pc1, unsigned (&pw)[16], f32x16 (&o)[2], float& carry, int kq, int hi) {
    f32x16 pn0 = f32x16{}, pn1 = f32x16{};
    float A[8], u0[16], u1[16];
#pragma unroll
    for (int sl = 0; sl < 4; ++sl) {
        const bf16x8 k0 = *(const LAS bf16x8*)(kbn + sl * 2048), k1 = *(const LAS bf16x8*)(kbn + sl * 2048 + 512);
#pragma unroll
        for (int j = 0; j < 4; ++j) { const int r = 4 * sl + j;
            float ua = ex2(__builtin_amdgcn_fmed3f(pc0[r], -200.f, 30.f)), ub = ex2(__builtin_amdgcn_fmed3f(pc1[r], -200.f, 30.f));
            if (MASK) { const int kr = kq + (r & 3) + 8 * (r >> 2); ua = (kr < 0) ? ua : 0.f; ub = (kr + 32 < 0) ? ub : 0.f; }
            u0[r] = ua; u1[r] = ub; }
        A[sl] = ((1.f + u0[4 * sl]) * (1.f + u0[4 * sl + 1])) * ((1.f + u0[4 * sl + 2]) * (1.f + u0[4 * sl + 3]));
        A[4 + sl] = ((1.f + u1[4 * sl]) * (1.f + u1[4 * sl + 1])) * ((1.f + u1[4 * sl + 2]) * (1.f + u1[4 * sl + 3]));
        pn0 = __builtin_amdgcn_mfma_f32_32x32x16_bf16(k0, qr[sl], pn0, 0, 0, 0); pn1 = __builtin_amdgcn_mfma_f32_32x32x16_bf16(k1, qr[sl], pn1, 0, 0, 0);
        __builtin_amdgcn_sched_group_barrier(0x100, 2, 0); __builtin_amdgcn_sched_group_barrier(0x2, 64, 0); __builtin_amdgcn_sched_group_barrier(0x8, 2, 0);
        __builtin_amdgcn_sched_barrier(0);
    }
    float Bo[8], R[8];
#pragma unroll
    for (int g = 0; g < 8; ++g) Bo[g] = other_half(A[g], hi);
    R[7] = carry;
#pragma unroll
    for (int g = 6; g >= 0; --g) R[g] = R[g + 1] * (A[g + 1] * Bo[g + 1]);
    carry = R[0] * (A[0] * Bo[0]);
#pragma unroll
    for (int kg = 0; kg < 4; ++kg) {
        s16x4 lo0, hh0, lo1, hh1;
        if (DO_PV) { lo0 = vtr(vbp + kg * 1024); hh0 = vtr(vbp + kg * 1024 + 512); lo1 = vtr(vbp + 4096 + kg * 1024); hh1 = vtr(vbp + 4096 + kg * 1024 + 512); }
        unsigned nw[4];
#pragma unroll
        for (int gi = 0; gi < 2; ++gi) { const int g = 2 * kg + gi;
            const float ua = (g < 4) ? u0[4 * g] : u1[4 * (g - 4)], ub = (g < 4) ? u0[4 * g + 1] : u1[4 * (g - 4) + 1], uc = (g < 4) ? u0[4 * g + 2] : u1[4 * (g - 4) + 2], ud = (g < 4) ? u0[4 * g + 3] : u1[4 * (g - 4) + 3];
            const float e0 = rcpf_((R[g] * (hi ? 1.f : Bo[g])) * A[g]);
            const float e1 = __builtin_fmaf(e0, ua, e0), e2 = __builtin_fmaf(e1, ub, e1), e3 = __builtin_fmaf(e2, uc, e2);
            nw[2 * gi] = cvt_pk_bf16(ua * e0, ub * e1); nw[2 * gi + 1] = cvt_pk_bf16(uc * e2, ud * e3); }
        if (DO_PV) { const bf16x8 pa = __builtin_bit_cast(bf16x8, (v4u){pw[4 * kg], pw[4 * kg + 1], pw[4 * kg + 2], pw[4 * kg + 3]});
            o[0] = __builtin_amdgcn_mfma_f32_32x32x16_bf16(pa, MK8(lo0, hh0), o[0], 0, 0, 0); o[1] = __builtin_amdgcn_mfma_f32_32x32x16_bf16(pa, MK8(lo1, hh1), o[1], 0, 0, 0);
            __builtin_amdgcn_sched_group_barrier(0x100, 4, 0); __builtin_amdgcn_sched_group_barrier(0x2, 64, 0); __builtin_amdgcn_sched_group_barrier(0x8, 2, 0); }
        __builtin_amdgcn_sched_barrier(0);
#pragma unroll
        for (int j = 0; j < 4; ++j) pw[4 * kg + j] = nw[j];
    }
    pc0 = pn0; pc1 = pn1;
}

__device__ __forceinline__ void sb_attn_unit(LAS unsigned char* lds, int b, int h, int qb, const bf16* Q, const bf16* K, const bf16* V, bf16* O  , const float* gq, const float* gk, const int wid) {
    const int lane = lane_fresh(), tid = wid * 64 + lane, r32 = lane & 31, hi = lane >> 5;
    const size_t rowbase = (size_t)b * SEQ; const int q0 = qb * 256;
    const int rb = (wid < 4) ? wid : 11 - wid;
    const bf16* Qw = Q + (rowbase + q0 + rb * 32) * 512 + h * 64;
    const bf16* Kh = K + rowbase * 512 + h * 64; const bf16* Vh = V + rowbase * 512 + h * 64;
    const int kkey = tid >> 3, kch = tid & 7;
    const bf16* ksrc = Kh + (size_t)kkey * 512 + kch * 8;
    const bf16* vsrc = Vh + (size_t)(16 * (wid & 3) + (lane >> 2)) * 512 + (wid >> 2) * 32 + (lane & 3) * 8;
    const int kstoff = kch * 1024 + kkey * 16;
    const int stoff = wid * 1024 + lane * 16;
    float gkr[8];
#pragma unroll
    for (int j = 0; j < 8; ++j) gkr[j] = gk[kch * 8 + j];
    bf16x8 qr[4];
    { v4u qw[4]; float ss = 0.f;
#pragma unroll
      for (int d0 = 0; d0 < 4; ++d0) { qw[d0] = *(const GAS v4u*)(Qw + (size_t)r32 * 512 + d0 * 16 + hi * 8); ss += sumsq8(qw[d0]); }
      ss += other_half(ss, hi);
      const float rstd = (0.125f * LOG2E) / sqrtf(ss * (1.f / 64.f) + EPS);
#pragma unroll
      for (int d0 = 0; d0 < 4; ++d0) { float g[8];
#pragma unroll
          for (int j = 0; j < 8; ++j) g[j] = gq[d0 * 16 + hi * 8 + j];
          qr[d0] = __builtin_bit_cast(bf16x8, scale8(qw[d0], rstd, g)); } }
    const int NT = (q0 + 256) / 64, NG = NT / 2;
    f32x16 o[2]; o[0] = f32x16{}; o[1] = f32x16{};
    float carry = 1.f;
    const int kfo = hi * 1024 + r32 * 16;
    const int vfo = ((lane >> 4) & 1) * 32 + (lane & 3) * 8 + (4 * hi + ((lane & 15) >> 2)) * 64;
    constexpr int VB = 49152;
    constexpr int SB_FLAG = 98304;
    constexpr float SB_DONE_D = 1099511627776.f;
#define SB_LOADK(gg, dst) do { _Pragma("unroll") for (int i_ = 0; i_ < 2; ++i_) dst[i_] = *(const GAS v4u*)(ksrc + (size_t)(NT - 1 - 2 * (gg) - i_) * 64 * 512); } while (0)
#define SB_LOADV(gg, dst) do { _Pragma("unroll") for (int i_ = 0; i_ < 2; ++i_) dst[i_] = *(const GAS v4u*)(vsrc + (size_t)(NT - 1 - 2 * (gg) - i_) * 64 * 512); } while (0)
#define SB_STOREK(gg, src) do { _Pragma("unroll") for (int i_ = 0; i_ < 2; ++i_) { float ss_ = sumsq8(src[i_]); ss_ += swz_xor<1>(ss_); ss_ += swz_xor<2>(ss_); ss_ += swz_xor<4>(ss_); \
        *(LAS v4u*)(lds + ((gg) % 3) * 16384 + i_ * 8192 + kstoff) = scale8(src[i_], __builtin_amdgcn_rsqf(ss_ * (1.f / 64.f) + EPS), gkr); } } while (0)
#define SB_STOREV(gg, src) do { _Pragma("unroll") for (int i_ = 0; i_ < 2; ++i_) *(LAS v4u*)(lds + VB + ((gg) % 3) * 16384 + i_ * 8192 + stoff) = src[i_]; } while (0)
#define SB_KB(i) (lds + (((i) >> 1) % 3) * 16384 + ((i) & 1) * 8192 + kfo)
#define SB_VBASE(i) (lds + VB + (((i) >> 1) % 3) * 16384 + ((i) & 1) * 8192 + vfo)
    v4u kreg[2], vreg[2];
    if (tid < 4) *(volatile LAS unsigned*)(lds + SB_FLAG + 4 * tid) = 0u;
    SB_LOADK(0, kreg); SB_LOADV(0, vreg); SB_STOREK(0, kreg); SB_STOREV(0, vreg);
    if (NG > 1) { SB_LOADK(1, kreg); SB_STOREK(1, kreg); SB_LOADV(1, vreg); }
    if (NG > 2) SB_LOADK(2, kreg);
    __syncthreads();
    f32x16 pc0 = f32x16{}, pc1 = f32x16{}; unsigned pw[16];
#pragma unroll
    for (int i = 0; i < 16; ++i) pw[i] = 0u;
    const int i0 = 3 - (rb >> 1);
    { const LAS unsigned char* kb = SB_KB(i0);
#pragma unroll
      for (int d0 = 0; d0 < 4; ++d0) { const bf16x8 k0 = *(const LAS bf16x8*)(kb + d0 * 2048), k1 = *(const LAS bf16x8*)(kb + d0 * 2048 + 512);
          pc0 = __builtin_amdgcn_mfma_f32_32x32x16_bf16(k0, qr[d0], pc0, 0, 0, 0); pc1 = __builtin_amdgcn_mfma_f32_32x32x16_bf16(k1, qr[d0], pc1, 0, 0, 0); } }
    const int kq0 = 4 * hi - (rb * 32 + r32);
#define SB_STAGE(g) do { __builtin_amdgcn_sched_barrier(0); if ((g) + 1 < NG) SB_STOREK((g) + 1, kreg); SB_STOREV((g), vreg); if ((g) + 2 < NG) SB_LOADK((g) + 2, kreg); if ((g) + 1 < NG) SB_LOADV((g) + 1, vreg); __syncthreads(); __builtin_amdgcn_sched_barrier(0); } while (0)
#define SB_DRAIN(i) do { const LAS unsigned char* vbp_ = SB_VBASE(i); _Pragma("unroll") for (int kg = 0; kg < 4; ++kg) { \
        const bf16x8 pa = __builtin_bit_cast(bf16x8, (v4u){pw[4 * kg], pw[4 * kg + 1], pw[4 * kg + 2], pw[4 * kg + 3]}); \
        _Pragma("unroll") for (int d0 = 0; d0 < 2; ++d0) { const s16x4 lo = vtr(vbp_ + d0 * 4096 + kg * 1024), hh = vtr(vbp_ + d0 * 4096 + kg * 1024 + 512); \
            o[d0] = __builtin_amdgcn_mfma_f32_32x32x16_bf16(pa, MK8(lo, hh), o[d0], 0, 0, 0); } } } while (0)
    bool wdone = false; int i = 0;
#pragma unroll 1
    for (; i < 4 && !wdone; ++i) {
        if (i == 2) SB_STAGE(1);
        if (i >= i0) {
            sb2_body<true, true>(SB_KB(i + 1), SB_VBASE(i > i0 ? i - 1 : i), qr, pc0, pc1, pw, o, carry, 64 * (3 - i) + kq0, hi);
            wdone = __builtin_amdgcn_ballot_w64(!(carry >= SB_DONE_D)) == 0ull; }
    }
    if (!wdone) {
#pragma unroll 1
        for (; i < NT; ++i) {
            if (!(i & 1)) { const int g_ = i >> 1;
                if (tid == 0) *(volatile LAS unsigned*)(lds + SB_FLAG + 4 * ((g_ + 1) & 3)) = 0u;
                if (lane == 0) *(volatile LAS unsigned*)(lds + SB_FLAG + 4 * (g_ & 3)) = 1u;
                SB_STAGE(g_); }
            sb2_body<false, true>(SB_KB(i + 1), SB_VBASE(i - 1), qr, pc0, pc1, pw, o, carry, 0, hi);
            if (__builtin_amdgcn_ballot_w64(!(carry >= SB_DONE_D)) == 0ull) { ++i; break; }
        }
    }
    SB_DRAIN(i - 1);
#pragma unroll 1
    for (; i < NT; ++i) {
        if (i == 2) SB_STAGE(1);
        else if (i >= 4 && !(i & 1)) { const int g_ = i >> 1;
            if (tid == 0) *(volatile LAS unsigned*)(lds + SB_FLAG + 4 * ((g_ + 1) & 3)) = 0u;
            SB_STAGE(g_);
            if (*(volatile LAS unsigned*)(lds + SB_FLAG + 4 * (g_ & 3)) == 0u) break; }
    }
#undef SB_STAGE
#undef SB_DRAIN
#undef SB_LOADK
#undef SB_LOADV
#undef SB_STOREK
#undef SB_STOREV
#undef SB_KB
#undef SB_VBASE
    __syncthreads();
    { LAS bf16* stg = (LAS bf16*)(lds + wid * 4096);
#pragma unroll
      for (int r = 0; r < 16; ++r) { const int orow = crow(r, hi);
#pragma unroll
          for (int d0 = 0; d0 < 2; ++d0) stg[orow * 64 + d0 * 32 + r32] = (bf16)f2bf(o[d0][r]); }
      LDS_WAIT();
      bf16* Ow = O + (rowbase + q0 + rb * 32) * 1536 + h * 64;
#pragma unroll
      for (int i = 0; i < 4; ++i) { const int row = i * 8 + (lane >> 3), ch = lane & 7; const v4u v = *(const LAS v4u*)(stg + row * 64 + ch * 8); *(GAS v4u*)(Ow + (size_t)row * 1536 + ch * 8) = v; } }
    __syncthreads();
}

__device__ __forceinline__ void ca_unit(LAS unsigned char* lds, int b, int h, int qb, const bf16* Q, const bf16* MKp, const bf16* MVp, bf16* O  , const float* gq, const float* gk, const int wid) {
    const int lane = lane_fresh(), tid = wid * 64 + lane, r32 = lane & 31, hi = lane >> 5;
    const bf16* Kh = MKp + (size_t)b * 256 * 512 + h * 128; const bf16* Vh = MVp + (size_t)b * 256 * 512 + h * 128;
    { float gkr[8];
#pragma unroll
      for (int j = 0; j < 8; ++j) gkr[j] = gk[(tid & 15) * 8 + j];
      v4u kin[8], vin[8];
#pragma unroll
      for (int i = 0; i < 8; ++i) { const int p = tid + 512 * i, key = p >> 4, c = p & 15;
        kin[i] = *(const GAS v4u*)(Kh + (size_t)key * 512 + c * 8); vin[i] = *(const GAS v4u*)(Vh + (size_t)key * 512 + c * 8); }
#pragma unroll
      for (int i = 0; i < 8; ++i) { const int p = tid + 512 * i, key = p >> 4, c = p & 15;
        v4u kv = kin[i]; const v4u vv = vin[i];
        float ss = sumsq8(kv); ss += swz_xor<1>(ss); ss += swz_xor<2>(ss); ss += swz_xor<4>(ss); ss += swz_xor<8>(ss);
        kv = scale8(kv, 1.f / sqrtf(ss * (1.f / 128.f) + EPS), gkr);
        *(LAS v4u*)(lds + c * 4096 + key * 16) = kv;
        *(LAS v4u*)(lds + 65536 + ((c >> 2) * 16 + (key >> 4)) * 1024 + (key & 15) * 64 + (c & 3) * 16) = vv; } }
    const size_t qrow = (size_t)b * SEQ + qb * 256 + wid * 32;
    bf16x8 qr[8];
    { v4u qw[8]; float ss = 0.f;
#pragma unroll
      for (int d0 = 0; d0 < 8; ++d0) { qw[d0] = *(const GAS v4u*)(Q + (qrow + r32) * 512 + h * 128 + d0 * 16 + hi * 8); ss += sumsq8(qw[d0]); }
      ss += other_half(ss, hi);
      const float rstd = (0.08838834764831845f * LOG2E) / sqrtf(ss * (1.f / 128.f) + EPS);
#pragma unroll
      for (int d0 = 0; d0 < 8; ++d0) { float g[8];
#pragma unroll
          for (int j = 0; j < 8; ++j) g[j] = gq[d0 * 16 + hi * 8 + j];
          qr[d0] = __builtin_bit_cast(bf16x8, scale8(qw[d0], rstd, g)); } }
    __syncthreads();
    const LAS unsigned char* kb = lds + hi * 4096 + r32 * 16;
    float mx;
    { float ga = fmaxf(fabsf(gq[lane]), fabsf(gq[64 + lane])), gb = fmaxf(fabsf(gk[lane]), fabsf(gk[64 + lane]));
      ga = fmaxf(ga, swz_xor<1>(ga)); ga = fmaxf(ga, swz_xor<2>(ga)); ga = fmaxf(ga, swz_xor<4>(ga)); ga = fmaxf(ga, swz_xor<8>(ga)); ga = fmaxf(ga, swz_xor<16>(ga)); ga = fmaxf(ga, other_half(ga, hi));
      gb = fmaxf(gb, swz_xor<1>(gb)); gb = fmaxf(gb, swz_xor<2>(gb)); gb = fmaxf(gb, swz_xor<4>(gb)); gb = fmaxf(gb, swz_xor<8>(gb)); gb = fmaxf(gb, swz_xor<16>(gb)); gb = fmaxf(gb, other_half(gb, hi));
      mx = 128.f * ga * gb * (0.08838834764831845f * LOG2E) * 1.01f; }
    if (mx > 60.f) {
        mx = -INFINITY;
#pragma unroll 1
        for (int kblk = 0; kblk < 8; ++kblk) { f32x16 s = f32x16{};
#pragma unroll
            for (int d0 = 0; d0 < 8; ++d0) s = __builtin_amdgcn_mfma_f32_32x32x16_bf16(*(const LAS bf16x8*)(kb + d0 * 8192 + kblk * 512), qr[d0], s, 0, 0, 0);
#pragma unroll
            for (int r = 0; r < 16; ++r) mx = fmaxf(mx, s[r]); }
        mx = fmaxf(mx, other_half(mx, hi)); }
    float l = 0.f; f32x16 o[4]; o[0] = f32x16{}; o[1] = f32x16{}; o[2] = f32x16{}; o[3] = f32x16{};
    const LAS unsigned char* vb = lds + 65536 + ((lane >> 4) & 1) * 32 + (lane & 3) * 8 + (4 * hi + ((lane & 15) >> 2)) * 64;
#pragma unroll 1
    for (int kblk = 0; kblk < 8; ++kblk) { f32x16 s = f32x16{};
#pragma unroll
        for (int d0 = 0; d0 < 8; ++d0) s = __builtin_amdgcn_mfma_f32_32x32x16_bf16(*(const LAS bf16x8*)(kb + d0 * 8192 + kblk * 512), qr[d0], s, 0, 0, 0);
        unsigned pw[8];
#pragma unroll
        for (int r = 0; r < 16; r += 2) { const float p0 = ex2(s[r] - mx), p1 = ex2(s[r + 1] - mx); l += p0 + p1; pw[r >> 1] = cvt_pk_bf16(p0, p1); }
#pragma unroll
        for (int ks = 0; ks < 2; ++ks) { const int kg = kblk * 2 + ks;
            const bf16x8 pa = __builtin_bit_cast(bf16x8, (v4u){pw[4 * ks], pw[4 * ks + 1], pw[4 * ks + 2], pw[4 * ks + 3]});
#pragma unroll
            for (int d0 = 0; d0 < 4; ++d0) { const s16x4 lo = vtr(vb + d0 * 16384 + kg * 1024), hh = vtr(vb + d0 * 16384 + kg * 1024 + 512);
                o[d0] = __builtin_amdgcn_mfma_f32_32x32x16_bf16(pa, MK8(lo, hh), o[d0], 0, 0, 0); } }
    }
    l += other_half(l, hi);
    LAS float* wsf = (LAS float*)(lds + XS_OFF) + wid * 32;
    if (hi == 0) wsf[r32] = 1.f / l;
    __syncthreads();
    { LAS bf16* stg = (LAS bf16*)(lds + wid * 8192);
#pragma unroll
      for (int r = 0; r < 16; ++r) { const int orow = crow(r, hi); const float rl = wsf[orow];
#pragma unroll
          for (int d0 = 0; d0 < 4; ++d0) stg[orow * 128 + d0 * 32 + r32] = (bf16)f2bf(o[d0][r] * rl); }
      LDS_WAIT();
      bf16* Ow = O + qrow * 1536 + h * 128;
#pragma unroll
      for (int i = 0; i < 8; ++i) { const int row = i * 4 + (lane >> 4), ch = lane & 15; const v4u v = *(const LAS v4u*)(stg + row * 128 + ch * 8); *(GAS v4u*)(Ow + (size_t)row * 1536 + ch * 8) = v; } }
    __syncthreads();
}

__device__ __forceinline__ int vimg_off(int row, int col, int nkg) { return (col >> 5) * (nkg * 1024) + (row >> 4) * 1024 + (row & 15) * 64 + (col & 31) * 2; }

__device__ __forceinline__ void gla_cumsum(const float (&la)[8]  , int w, int d, LAS float* cumw, float (&cum)[8], float& last) {
    float c = 0.f;
#pragma unroll
    for (int i = 0; i < 8; ++i) { c += la[i]; cum[i] = c; }
    cumw[w * 64 + d] = c;
    __syncthreads();
    float off = 0.f, tot = 0.f;
#pragma unroll
    for (int j = 0; j < 8; ++j) { const float x = cumw[j * 64 + d]; tot += x; off += (j < w) ? x : 0.f; }
#pragma unroll
    for (int i = 0; i < 8; ++i) cum[i] += off;
    last = tot;
}

__device__ __forceinline__ void gla_stage1_unit(LAS unsigned char* lds, int unit, const bf16* GK, const bf16* GV, const float* LOGA, float* KV, float* DEC, const int w) {
    const int lane = lane_fresh(), tid = w * 64 + lane, r32 = lane & 31, hi = lane >> 5;
    const int bh = unit >> 6, n = unit & 63, b = bh >> 2, h = bh & 3; const size_t row0 = (size_t)b * SEQ + n * 64;
    LAS float* cumw = (LAS float*)(lds + XS_OFF);
    LAS unsigned char* KE = lds; LAS unsigned char* VI = lds + 8192;
    v4u vreg[2]; unsigned short kraw[8]; float la[8];
#pragma unroll
    for (int i = 0; i < 2; ++i) { const int p = tid + 512 * i, j = p >> 4, c = p & 15; vreg[i] = *(const GAS v4u*)(GV + (row0 + j) * 512 + h * 128 + c * 8); }
#pragma unroll
    for (int i = 0; i < 8; ++i) { const size_t o_ = (row0 + 8 * w + i) * 256 + h * 64 + lane; kraw[i] = *(const GAS unsigned short*)(GK + o_); la[i] = *(const GAS float*)(LOGA + o_); }
#pragma unroll
    for (int i = 0; i < 2; ++i) { const int p = tid + 512 * i, j = p >> 4, c = p & 15; *(LAS v4u*)(VI + vimg_off(j, c * 8, 4)) = vreg[i]; }
    float cum[8], last;
    gla_cumsum(la, w, lane, cumw, cum, last);
#pragma unroll
    for (int i = 0; i < 8; ++i) *(LAS bf16*)(KE + vimg_off(8 * w + i, lane, 4)) = (bf16)f2bf(bf2f(kraw[i]) * __expf(last - cum[i]));
    if (w == 0) DEC[(size_t)unit * 64 + lane] = __expf(last);
    __syncthreads();
    const int db = w >> 2, vb = w & 3;
    const int fo = ((lane >> 4) & 1) * 32 + (lane & 3) * 8 + (4 * hi + ((lane & 15) >> 2)) * 64;
    f32x16 acc = f32x16{};
#pragma unroll
    for (int ks = 0; ks < 4; ++ks) {
        const s16x4 al = vtr(KE + fo + db * 4096 + ks * 1024), ah = vtr(KE + fo + db * 4096 + ks * 1024 + 512);
        const s16x4 bl = vtr(VI + fo + vb * 4096 + ks * 1024), bh_ = vtr(VI + fo + vb * 4096 + ks * 1024 + 512);
        acc = __builtin_amdgcn_mfma_f32_32x32x16_bf16(MK8(al, ah), MK8(bl, bh_), acc, 0, 0, 0); }
    float* kvp = KV + (size_t)unit * 8192 + vb * 32 + r32;
#pragma unroll
    for (int r = 0; r < 16; ++r) kvp[(size_t)(32 * db + crow(r, hi)) * 128] = acc[r];
    __syncthreads();
}

__device__ __forceinline__ void gla_scan(const Frame& F, const float* __restrict__ KV, const float* __restrict__ DEC, bf16* __restrict__ STATE) {
    const int tid = F.wave * 64 + lane_fresh();
    for (int gid = F.vcu * 512 + tid; gid < 16 * 8192; gid += F.G * 512) {
        const int bh = gid >> 13, e = gid & 8191, d = e >> 7, v = e & 127; float S = 0.f;
        const int so = vimg_off(d, v, 4) >> 1;
        const float* kvp = KV + (size_t)bh * 64 * 8192 + e; const float* dp = DEC + (size_t)bh * 64 * 64 + d; bf16* sp = STATE + (size_t)bh * 64 * 8192 + so;
#pragma unroll 1
        for (int n0 = 0; n0 < 64; n0 += 16) {
            float kv[16], dc[16];
#pragma unroll
            for (int i = 0; i < 16; ++i) { kv[i] = kvp[(size_t)(n0 + i) * 8192]; dc[i] = dp[(n0 + i) * 64]; }
#pragma unroll
            for (int i = 0; i < 16; ++i) { sp[(size_t)(n0 + i) * 8192] = (bf16)f2bf(S); S = dc[i] * S + kv[i]; }
        }
    }
}

__device__ __forceinline__ void gla_stage3_unit(LAS unsigned char* lds, int unit, const bf16* GQ, const bf16* GK, const bf16* GV, const float* LOGA, const bf16* STATE, const bf16* GR, const float* og, bf16* OCAT, const int w) {
    const int lane = lane_fresh(), tid = w * 64 + lane, r32 = lane & 31, hi = lane >> 5;
    const int bh = unit >> 6, n = unit & 63, b = bh >> 2, h = bh & 3; const size_t row0 = (size_t)b * SEQ + n * 64;
    LAS float* cumw = (LAS float*)(lds + XS_OFF);
    LAS unsigned char* QD = lds; LAS unsigned char* KI = lds + 9216; LAS unsigned char* VI = lds + 18432; LAS unsigned char* SI = lds + 34816; LAS float* OF = (LAS float*)(lds + 51200);
    v4u vreg[2], sreg[2]; unsigned short qraw[8], kraw[8]; float la[8];
#pragma unroll
    for (int i = 0; i < 2; ++i) { const int p = tid + 512 * i, j = p >> 4, c = p & 15;
        vreg[i] = *(const GAS v4u*)(GV + (row0 + j) * 512 + h * 128 + c * 8); sreg[i] = *(const GAS v4u*)(STATE + (size_t)unit * 8192 + p * 8); }
#pragma unroll
    for (int i = 0; i < 8; ++i) { const size_t o_ = (row0 + 8 * w + i) * 256 + h * 64 + lane; qraw[i] = *(const GAS unsigned short*)(GQ + o_); kraw[i] = *(const GAS unsigned short*)(GK + o_); la[i] = *(const GAS float*)(LOGA + o_); }
    const float g0 = *(const GAS float*)(og + lane), g1 = *(const GAS float*)(og + 64 + lane);
    unsigned short grr[8][2];
#pragma unroll
    for (int i = 0; i < 8; ++i) { const size_t gro = (row0 + 8 * w + i) * 512 + h * 128 + lane; grr[i][0] = *(const GAS unsigned short*)(GR + gro); grr[i][1] = *(const GAS unsigned short*)(GR + gro + 64); }
#pragma unroll
    for (int i = 0; i < 2; ++i) { const int p = tid + 512 * i, j = p >> 4, c = p & 15; *(LAS v4u*)(VI + vimg_off(j, c * 8, 4)) = vreg[i]; *(LAS v4u*)(SI + p * 16) = sreg[i]; }
    float qf[8], kf[8];
#pragma unroll
    for (int i = 0; i < 8; ++i) { qf[i] = bf2f(qraw[i]); kf[i] = bf2f(kraw[i]); }
    float cum[8], last;
    gla_cumsum(la, w, lane, cumw, cum, last);
#pragma unroll
    for (int i = 0; i < 8; ++i) { const float ec = __expf(cum[i]);
        *(LAS bf16*)(QD + (8 * w + i) * 144 + lane * 2) = (bf16)f2bf(qf[i] * 0.125f * ec);
        *(LAS bf16*)(KI + (8 * w + i) * 144 + lane * 2) = (bf16)f2bf(kf[i] * __expf(-cum[i])); }
    __syncthreads();
    const int ib = w >> 2, vb = w & 3;
    unsigned pw[16];
#pragma unroll
    for (int jb = 0; jb < 2; ++jb) {
        f32x16 st = f32x16{};
        if (jb <= ib) {
#pragma unroll
            for (int d0 = 0; d0 < 4; ++d0) {
                const bf16x8 a = *(const LAS bf16x8*)(KI + (32 * jb + r32) * 144 + (16 * d0 + 8 * hi) * 2), bq = *(const LAS bf16x8*)(QD + (32 * ib + r32) * 144 + (16 * d0 + 8 * hi) * 2);
                st = __builtin_amdgcn_mfma_f32_32x32x16_bf16(a, bq, st, 0, 0, 0); }
        }
#pragma unroll
        for (int r = 0; r < 16; r += 2) { const int j0 = 32 * jb + crow(r, hi), i_ = 32 * ib + r32;
            const float p0 = (j0 <= i_) ? st[r] : 0.f, p1 = (j0 + 1 <= i_) ? st[r + 1] : 0.f; pw[jb * 8 + (r >> 1)] = cvt_pk_bf16(p0, p1); }
    }
    const int fo = ((lane >> 4) & 1) * 32 + (lane & 3) * 8 + (4 * hi + ((lane & 15) >> 2)) * 64;
    f32x16 o = f32x16{};
#pragma unroll
    for (int kg = 0; kg < 4; ++kg) {
        const bf16x8 pa = __builtin_bit_cast(bf16x8, (v4u){pw[4 * kg], pw[4 * kg + 1], pw[4 * kg + 2], pw[4 * kg + 3]});
        const s16x4 vl = vtr(VI + fo + vb * 4096 + kg * 1024), vh = vtr(VI + fo + vb * 4096 + kg * 1024 + 512);
        o = __builtin_amdgcn_mfma_f32_32x32x16_bf16(pa, MK8(vl, vh), o, 0, 0, 0);
        const v2u q0 = *(const LAS v2u*)(QD + (32 * ib + r32) * 144 + (16 * kg + 4 * hi) * 2), q1 = *(const LAS v2u*)(QD + (32 * ib + r32) * 144 + (16 * kg + 8 + 4 * hi) * 2);
        const bf16x8 qa = __builtin_bit_cast(bf16x8, (v4u){q0.x, q0.y, q1.x, q1.y});
        const s16x4 sl = vtr(SI + fo + vb * 4096 + kg * 1024), sh = vtr(SI + fo + vb * 4096 + kg * 1024 + 512);
        o = __builtin_amdgcn_mfma_f32_32x32x16_bf16(qa, MK8(sl, sh), o, 0, 0, 0);
    }
#pragma unroll
    for (int r = 0; r < 16; ++r) OF[(32 * ib + crow(r, hi)) * 132 + 32 * vb + r32] = o[r];
    __syncthreads();
#pragma unroll
    for (int i = 0; i < 8; ++i) { const int row = 8 * w + i; const float x0 = OF[row * 132 + lane], x1 = OF[row * 132 + 64 + lane];
        const float rstd = __builtin_amdgcn_rsqf(wave_sum(x0 * x0 + x1 * x1, hi) * (1.f / 128.f) + EPS);
        const size_t oo = (row0 + row) * 1536 + 512 + h * 128 + lane;
        *(GAS bf16*)(OCAT + oo) = (bf16)f2bf(x0 * rstd * g0 * bf2f(grr[i][0])); *(GAS bf16*)(OCAT + oo + 64) = (bf16)f2bf(x1 * rstd * g1 * bf2f(grr[i][1])); }
    __syncthreads();
}

__device__ __forceinline__ void phase_route(const Frame& F, const float* x, const float* gain, const float* wr  , unsigned* gcnt  , unsigned* ROUTE) {
    LAS unsigned* cntl = (LAS unsigned*)(F.lds); LAS unsigned* gb = cntl + 8; LAS unsigned* tok = cntl + 16;
    const int lane = lane_fresh(), w = F.wave, tid = w * 64 + lane;
    f32x4 wq[16][2];
#pragma unroll
    for (int j = 0; j < 4; ++j)
#pragma unroll
        for (int c = 0; c < 4; ++c) { const GAS f32x4* wp = (const GAS f32x4*)(wr + (size_t)(256 * j + 4 * lane + c) * 8); wq[4 * j + c][0] = wp[0]; wq[4 * j + c][1] = wp[1]; }
    f32x4 gq4[4];
#pragma unroll
    for (int j = 0; j < 4; ++j) gq4[j] = *((const GAS f32x4*)gain + lane + 64 * j);
    for (int blk = F.vcu; blk < MTOK / 64; blk += F.G) {
        if (tid < 8) cntl[tid] = 0u;
        __syncthreads();
        f32x4 vn[4];
#pragma unroll
        for (int j = 0; j < 4; ++j) vn[j] = *((const GAS f32x4*)(x + (size_t)(blk * 64 + w * 8) * 1024) + lane + 64 * j);
#pragma unroll 1
        for (int i = 0; i < 8; ++i) {
            const int m = blk * 64 + w * 8 + i;
            f32x4 v[4]; float s = 0.f;
#pragma unroll
            for (int j = 0; j < 4; ++j) { v[j] = vn[j]; s += (v[j].x * v[j].x + v[j].y * v[j].y) + (v[j].z * v[j].z + v[j].w * v[j].w); }
            if (i < 7) {
#pragma unroll
                for (int j = 0; j < 4; ++j) vn[j] = *((const GAS f32x4*)(x + (size_t)(m + 1) * 1024) + lane + 64 * j); }
            const float rstd = 1.f / sqrtf(wave_sum(s, lane >> 5) * (1.f / 1024.f) + EPS);
            float lg[8];
#pragma unroll
            for (int e = 0; e < 8; ++e) lg[e] = 0.f;
            GAS unsigned* o4 = (GAS unsigned*)(wsp<unsigned char>(F, WS_HBUF) + (size_t)m * 1024) + lane;
#pragma unroll
            for (int j = 0; j < 4; ++j) { const f32x4 y = v[j] * rstd * gq4[j];
                o4[64 * j] = pk4_fp8(y.x, y.y, y.z, y.w);
#pragma unroll
                for (int c = 0; c < 4; ++c) { const f32x4 w0 = wq[4 * j + c][0], w1 = wq[4 * j + c][1]; const float yc = y[c];
                    lg[0] += yc * w0.x; lg[1] += yc * w0.y; lg[2] += yc * w0.z; lg[3] += yc * w0.w; lg[4] += yc * w1.x; lg[5] += yc * w1.y; lg[6] += yc * w1.z; lg[7] += yc * w1.w; } }
#pragma unroll
            for (int e = 0; e < 8; ++e) lg[e] = wave_sum(lg[e], lane >> 5);
            if (lane == 0) {
                int e1 = 0; float v1 = lg[0];
#pragma unroll
                for (int e = 1; e < 8; ++e) if (lg[e] > v1) { v1 = lg[e]; e1 = e; }
                int e2 = -1; float v2 = -INFINITY;
#pragma unroll
                for (int e = 0; e < 8; ++e) if (e != e1 && lg[e] > v2) { v2 = lg[e]; e2 = e; }
                const float w2 = 1.f / (1.f + __expf(v1 - v2)), w1 = 1.f - w2;
                const unsigned p1 = atomicAdd((unsigned*)(cntl + e1), 1u), p2 = atomicAdd((unsigned*)(cntl + e2), 1u);
                LAS unsigned* t = tok + (w * 8 + i) * 6; t[0] = (unsigned)e1; t[1] = p1; t[2] = (unsigned)e2; t[3] = p2; t[4] = __float_as_uint(w1); t[5] = __float_as_uint(w2);
            }
        }
        __syncthreads();
        if (tid < 8) gb[tid] = __hip_atomic_fetch_add(gcnt + tid * 64, cntl[tid], __ATOMIC_RELAXED, __HIP_MEMORY_SCOPE_AGENT);
        __syncthreads();
        if (tid < 64) { LAS unsigned* t = tok + tid * 6; unsigned* r = ROUTE + (size_t)(blk * 64 + tid) * 8;
            r[0] = t[0]; r[1] = gb[t[0]] + t[1]; r[2] = t[2]; r[3] = gb[t[2]] + t[3]; r[4] = t[4]; r[5] = t[5]; }
        __syncthreads();
    }
}
__device__ __forceinline__ void moe_tile_starts(const unsigned* gcnt, int (&rs)[8]) {
    int t = 0;
#pragma unroll
    for (int e = 0; e < 8; ++e) { rs[e] = t * 256; t += ((int)gcnt[e * 64] + 255) >> 8; }
}
__device__ __forceinline__ void phase_scatter(const Frame& F, const unsigned* gcnt, unsigned* ROUTE) {
    int rs[8]; moe_tile_starts(gcnt, rs);
    const int gw = F.vcu * 8 + F.wave, NGW = F.G * 8, lane = lane_fresh();
    const unsigned char* H = wsp<unsigned char>(F, WS_HBUF); unsigned char* AS = wsp<unsigned char>(F, WS_ASORT);
    for (int m0 = gw; m0 < MTOK; m0 += 4 * NGW) {
        v4u rt[4], a[4];
#pragma unroll
        for (int k = 0; k < 4; ++k) { const int m = m0 + k * NGW; if (m < MTOK) { rt[k] = *(const GAS v4u*)(ROUTE + (size_t)m * 8); a[k] = *((const GAS v4u*)(H + (size_t)m * 1024) + lane); } }
#pragma unroll
        for (int k = 0; k < 4; ++k) { const int m = m0 + k * NGW; if (m < MTOK) {
            const unsigned e1 = rt[k].x, p1 = rt[k].y, e2 = rt[k].z, p2 = rt[k].w; int b1 = 0, b2 = 0;
#pragma unroll
            for (int e = 0; e < 8; ++e) { b1 = (e1 == (unsigned)e) ? rs[e] : b1; b2 = (e2 == (unsigned)e) ? rs[e] : b2; }
            const unsigned s1 = (unsigned)b1 + p1, s2 = (unsigned)b2 + p2;
            *((GAS v4u*)(AS + (size_t)s1 * 1024) + lane) = a[k]; *((GAS v4u*)(AS + (size_t)s2 * 1024) + lane) = a[k];
            if (lane == 0) { unsigned* r = ROUTE + (size_t)m * 8; r[6] = s1; r[7] = s2; } } }
    }
}
__device__ __forceinline__ v4u ypart_sum(const bf16* YP, unsigned prow, int lane, int j) {
    float a[8]; v4u q[pg8::GroupedOrder::KSPL];
#pragma unroll
    for (int i = 0; i < 8; ++i) a[i] = 0.f;
#pragma unroll
    for (int ks = 0; ks < pg8::GroupedOrder::KSPL; ++ks) q[ks] = *((const GAS v4u*)(YP + ((size_t)ks * YPART_ROWS + prow) * 1024) + lane + 64 * j);
#pragma unroll
    for (int ks = 0; ks < pg8::GroupedOrder::KSPL; ++ks) { const v4u p = q[ks];
        a[0] += bflo(p.x); a[1] += bfhi(p.x); a[2] += bflo(p.y); a[3] += bfhi(p.y); a[4] += bflo(p.z); a[5] += bfhi(p.z); a[6] += bflo(p.w); a[7] += bfhi(p.w); }
    v4u o; o.x = pk2(a[0], a[1]); o.y = pk2(a[2], a[3]); o.z = pk2(a[4], a[5]); o.w = pk2(a[6], a[7]); return o;
}
__device__ __forceinline__ void phase_combine(const Frame& F, const unsigned* gcnt, const unsigned* ROUTE, float* out) {
    const int gw = F.vcu * 8 + F.wave, NGW = F.G * 8, lane = lane_fresh();
    const bf16* Y = wsp<bf16>(F, WS_YBUF); const bf16* YP = wsp<bf16>(F, WS_YPART);
    unsigned split0;
    { int t = 0;
#pragma unroll
      for (int e = 0; e < 8; ++e) t += ((int)gcnt[e * 64] + 255) >> 8;
      split0 = (unsigned)pg8::GroupedOrder::main_tiles(t, 4, F.G) * 256u; }
    for (int m0 = gw; m0 < MTOK; m0 += 4 * NGW) {
        v4u rt[4];
#pragma unroll
        for (int k = 0; k < 4; ++k) { const int m = m0 + k * NGW; if (m < MTOK) rt[k] = *((const GAS v4u*)(ROUTE + (size_t)m * 8) + 1); }
        v4u ya[4][2], yc[4][2]; f32x4 o[4][4];
#pragma unroll
        for (int k = 0; k < 4; ++k) { const int m = m0 + k * NGW; if (m < MTOK) {
            const GAS v4u* y1 = (const GAS v4u*)(Y + (size_t)rt[k].z * 1024) + lane; const GAS v4u* y2 = (const GAS v4u*)(Y + (size_t)rt[k].w * 1024) + lane;
            const GAS f32x4* op = (const GAS f32x4*)(out + (size_t)m * 1024) + 2 * lane;
#pragma unroll
            for (int j = 0; j < 2; ++j) { ya[k][j] = y1[64 * j]; yc[k][j] = y2[64 * j]; o[k][2 * j] = op[128 * j]; o[k][2 * j + 1] = op[128 * j + 1]; } } }
#pragma unroll
        for (int k = 0; k < 4; ++k) { const int m = m0 + k * NGW; if (m < MTOK) {
            if (rt[k].z >= split0) { ya[k][0] = ypart_sum(YP, rt[k].z - split0, lane, 0); ya[k][1] = ypart_sum(YP, rt[k].z - split0, lane, 1); }
            if (rt[k].w >= split0) { yc[k][0] = ypart_sum(YP, rt[k].w - split0, lane, 0); yc[k][1] = ypart_sum(YP, rt[k].w - split0, lane, 1); } } }
#pragma unroll
        for (int k = 0; k < 4; ++k) { const int m = m0 + k * NGW; if (m < MTOK) {
            const float w1 = __uint_as_float(rt[k].x), w2 = __uint_as_float(rt[k].y);
            GAS f32x4* op = (GAS f32x4*)(out + (size_t)m * 1024) + 2 * lane;
#pragma unroll
            for (int j = 0; j < 2; ++j) { const v4u a = ya[k][j], c = yc[k][j]; f32x4 o0 = o[k][2 * j], o1 = o[k][2 * j + 1];
                o0.x += w1 * bflo(a.x) + w2 * bflo(c.x); o0.y += w1 * bfhi(a.x) + w2 * bfhi(c.x); o0.z += w1 * bflo(a.y) + w2 * bflo(c.y); o0.w += w1 * bfhi(a.y) + w2 * bfhi(c.y);
                o1.x += w1 * bflo(a.z) + w2 * bflo(c.z); o1.y += w1 * bfhi(a.z) + w2 * bfhi(c.z); o1.z += w1 * bflo(a.w) + w2 * bflo(c.w); o1.w += w1 * bfhi(a.w) + w2 * bfhi(c.w);
                op[128 * j] = o0; op[128 * j + 1] = o1; } } }
    }
}

constexpr int N_PHASES = 25;
struct Args { const float* in[N_IN]; float* out; unsigned char* ws; int ph_lo, ph_hi; };
static_assert(sizeof(Args) == N_IN * 8 + 8 + 8 + 8, "Args has no padding");

__global__ void __launch_bounds__(512, 2) mega_fwd(Args args) {
    extern __shared__ __attribute__((aligned(16))) unsigned char lds_raw[];
    Frame F;
    F.lds = (LAS unsigned char*)lds_raw;
    F.wave = __builtin_amdgcn_readfirstlane((int)threadIdx.x >> 6);
    F.G = gridDim.x; { const int bx = blockIdx.x; F.vcu = (F.G % 8 == 0) ? (bx % 8) * (F.G / 8) + bx / 8 : bx; }
    F.ws = args.ws; F.in = args.in; F.out = args.out;
    gu32* ctl = (gu32*)(F.ws + WS_CTL);
    volatile LAS unsigned* MISC = (volatile LAS unsigned*)(F.lds + MISC_OFF);
    for (int u = threadIdx.x; u < (XS_OFF - LDSCTL_OFF) / 4; u += 512) ((LAS unsigned*)(F.lds + LDSCTL_OFF))[u] = 0u;
    __syncthreads();
    const int lo = args.ph_lo, hi = args.ph_hi;
    XcdBarrier bar; bar.bar = (unsigned*)(ctl + CW_BAR); bar.x = 0; bar.st = nullptr;
    if (MK_ONE_LAUNCH || hi - lo > 1) bar = xcd_barrier_post((unsigned*)(ctl + CW_BAR), MISC + 8);
#ifndef DBG_MASK
#define DBG_MASK 0xFFFFFFFFu
#endif
#define ON(i) (((DBG_MASK) >> (i)) & 1u)
#if MK_ONE_LAUNCH
#define IN(k) true
#define SEAM(k) xcd_barrier(bar, F.wave == 0 && lane_fresh() == 0)
#else
#define IN(k) (lo <= (k) && (k) < hi)
#define SEAM(k) do { if (IN(k) && IN((k) + 1)) xcd_barrier(bar, F.wave == 0 && lane_fresh() == 0); } while (0)
#endif

    if (ON(0) && IN(0)) { phase_prologue(F); }
    SEAM(0);
    const Frame F0 = F;
#pragma unroll 1
    for (int l = 0; l < 2; ++l) {
        const int pb = 1 + 12 * l;
        Frame F = F0; int bidx = blockIdx.x;
        asm volatile("" : "+s"(F.G), "+s"(F.vcu), "+s"(bidx), "+s"(F.ws), "+s"(F.wave));
        bf16* HB = wsp<bf16>(F, WS_HBUF);
        if (IN(pb + 0)) {
            if (ON(1)) {
              { pg8::Gemm g{HB, wsp<bf16>(F, WS_WIN) + (size_t)l * IN_WP * 1024, MTOK, 3840, 1024, 0}; pg8::StaticOrder S; S.init(MTOK, 3840, F.G, bidx);
                epi::EpiInProj E{wsp<bf16>(F, WS_SBQ), wsp<bf16>(F, WS_SBK), wsp<bf16>(F, WS_SBV), wsp<bf16>(F, WS_GQ), wsp<bf16>(F, WS_GK), wsp<bf16>(F, WS_GV), wsp<bf16>(F, WS_GR), wsp<bf16>(F, WS_CAQ), wsp<bf16>(F, WS_GATES),
                                  wsp<float>(F, WS_LOGA), F.in[I_GAB] + l * 256, 1.f};
                pg8::gemm_phase<epi::EpiInProj, pg8::StaticOrder, true, PG8_SP2>(F.lds, g, S, E, F.wave); }
              { pg8::Gemm g{wsp<bf16>(F, WS_HB8), (const bf16*)(wsp<unsigned char>(F, WS_WIN) + (size_t)l * IN_WP * 2048 + (size_t)3840 * 2048), MTOK, 3072, 512, 0}; pg8::StaticOrder S; S.init(MTOK, 3072, F.G, bidx);
                epi::EpiGates E{wsp<bf16>(F, WS_GATES), 1.f / 32.f};
                pg8::gemm_phase<epi::EpiGates, pg8::StaticOrder, true, PG8_SP2, 1>(F.lds, g, S, E, F.wave); } }
            if (ON(2) && l == 0) {
#pragma unroll 1
                for (int l2 = 0; l2 < 2; ++l2) {
                    pg8::Gemm g{wsp<bf16>(F, WS_HMEM) + (size_t)l2 * MMEM * 1024, wsp<bf16>(F, WS_WMKV) + (size_t)l2 * 1024 * 1024, MMEM, 1024, 1024, 0}; pg8::StaticOrder S;
                    S.init(MMEM, 1024, F.G, (bidx - (960 % F.G) - 16 * l2 + 2 * F.G) % F.G);
                    epi::EpiBf16Split E{wsp<bf16>(F, WS_MK) + (size_t)l2 * MMEM * 512, wsp<bf16>(F, WS_MV) + (size_t)l2 * MMEM * 512, 512, 2, 1.f};
                    pg8::gemm_phase<epi::EpiBf16Split, pg8::StaticOrder, true, PG8_SP2>(F.lds, g, S, E, F.wave); }
            }
        }
        SEAM(pb + 0);
        if (IN(pb + 2)) {
            if (ON(4)) for (int rep = 0; rep < DBG_REP_SB; ++rep) for (int p = F.vcu; p < 256; p += F.G) { const int bh = p >> 3, s = p & 7;
                sb_attn_unit(F.lds, bh >> 3, bh & 7, 15 - s, wsp<bf16>(F, WS_SBQ), wsp<bf16>(F, WS_SBK), wsp<bf16>(F, WS_SBV), wsp<bf16>(F, WS_OCAT), F.in[I_SBQG] + l * 64, F.in[I_SBKG] + l * 64, F.wave);
                sb_attn_unit(F.lds, bh >> 3, bh & 7, s, wsp<bf16>(F, WS_SBQ), wsp<bf16>(F, WS_SBK), wsp<bf16>(F, WS_SBV), wsp<bf16>(F, WS_OCAT), F.in[I_SBQG] + l * 64, F.in[I_SBKG] + l * 64, F.wave); }
            if (ON(5)) for (int u = F.vcu; u < 256; u += F.G)
                ca_unit(F.lds, u >> 6, (u >> 4) & 3, u & 15, wsp<bf16>(F, WS_CAQ), wsp<bf16>(F, WS_MK) + (size_t)l * MMEM * 512, wsp<bf16>(F, WS_MV) + (size_t)l * MMEM * 512, wsp<bf16>(F, WS_OCAT) + 1024, F.in[I_CAQG] + l * 128, F.in[I_CAKG] + l * 128, F.wave);
            if (ON(6)) for (int u = F.vcu; u < 1024; u += F.G)
                gla_stage1_unit(F.lds, u, wsp<bf16>(F, WS_GK), wsp<bf16>(F, WS_GV), wsp<float>(F, WS_LOGA), wsp<float>(F, WS_KV), wsp<float>(F, WS_DEC), F.wave);
        }
        SEAM(pb + 2);
        if (ON(7) && IN(pb + 3)) gla_scan(F, wsp<float>(F, WS_KV), wsp<float>(F, WS_DEC), wsp<bf16>(F, WS_STATE));
        SEAM(pb + 3);
        if (ON(8) && IN(pb + 4)) {
            for (int u = F.vcu; u < 1024; u += F.G)
                gla_stage3_unit(F.lds, u, wsp<bf16>(F, WS_GQ), wsp<bf16>(F, WS_GK), wsp<bf16>(F, WS_GV), wsp<float>(F, WS_LOGA), wsp<bf16>(F, WS_STATE), wsp<bf16>(F, WS_GR), F.in[I_GOG] + l * 128, wsp<bf16>(F, WS_OCAT), F.wave);
        }
        SEAM(pb + 4);
        if (ON(9) && IN(pb + 5)) {
            pg8::Gemm g{wsp<bf16>(F, WS_OCAT), wsp<bf16>(F, WS_WBR) + (size_t)l * 1024 * 1536, MTOK, 1024, 1536, 0}; pg8::StaticOrder S; S.init(MTOK, 1024, F.G, bidx);
            epi::EpiBranch E{wsp<bf16>(F, WS_GATES), wsp<bf16>(F, WS_MERGED)};
            pg8::gemm_phase<epi::EpiBranch, pg8::StaticOrder, false, PG8_SP2>(F.lds, g, S, E, F.wave);
        }
        SEAM(pb + 5);
        if (ON(10) && IN(pb + 6)) {
            pg8::Gemm g{wsp<bf16>(F, WS_MERGED), wsp<bf16>(F, WS_WOUT) + (size_t)l * 1024 * 1024, MTOK, 1024, 1024, 0}; pg8::StaticOrder S; S.init(MTOK, 1024, F.G, bidx);
            epi::EpiResF32 E{l == 0 ? F.in[I_X] : F.out, F.out, 1.f};
            pg8::gemm_phase<epi::EpiResF32, pg8::StaticOrder, false, PG8_SP2>(F.lds, g, S, E, F.wave);
        }
        SEAM(pb + 6);
        unsigned* gcnt = (unsigned*)(ctl + CW_CNT); unsigned* ROUTE = wsp<unsigned>(F, WS_ROUTE);
        if (l == 0) {
            if (ON(11) && IN(pb + 7)) phase_rms(F, F.out, F.in[I_FFNG]);
            SEAM(pb + 7);
            if (ON(12) && IN(pb + 9)) {
                pg8::Gemm g{HB, wsp<bf16>(F, WS_WGU0), MTOK, 2 * DFF, 1024, 0}; pg8::StaticOrder S; S.init(MTOK, 2 * DFF, F.G, bidx);
                epi::EpiSwiGLU<false> E{wsp<unsigned char>(F, WS_ACT), DFF, 1.f};
                pg8::gemm_phase<epi::EpiSwiGLU<false>, pg8::StaticOrder, true, PG8_SP2>(F.lds, g, S, E, F.wave);
            }
            SEAM(pb + 9);
            if (ON(13) && IN(pb + 10)) {
                pg8::Gemm g{wsp<bf16>(F, WS_ACT), wsp<bf16>(F, WS_WDN0), MTOK, 1024, DFF, 0}; pg8::StaticOrder S; S.init(MTOK, 1024, F.G, bidx);
                epi::EpiResF32 E{F.out, F.out, 1.f};
                pg8::gemm_phase<epi::EpiResF32, pg8::StaticOrder, false, PG8_SP2>(F.lds, g, S, E, F.wave);
            }
            SEAM(pb + 10);
            if (ON(11) && IN(pb + 11)) { if (L1_INPROJ_FP8) phase_rms_fp8(F, F.out, F.in[I_MIXG] + 1024); else phase_rms(F, F.out, F.in[I_MIXG] + 1024, true); }
            SEAM(pb + 11);
        } else {
            if (ON(14) && IN(pb + 7)) phase_route(F, F.out, F.in[I_FFNG] + 1024, F.in[I_ROUTER], gcnt, ROUTE);
            SEAM(pb + 7);
            if (ON(15) && IN(pb + 8)) phase_scatter(F, gcnt, ROUTE);
            SEAM(pb + 8);
            if (ON(16) && IN(pb + 9)) {
                pg8::Gemm g{wsp<bf16>(F, WS_ASORT), wsp<bf16>(F, WS_WGUE), 0, 2 * DFFE, 1024 / 2, (size_t)2 * DFFE * 1024}; pg8::GroupedOrder S; S.init(gcnt, 2 * DFFE, F.G, bidx);
                epi::EpiSwiGLU<true> E{wsp<unsigned char>(F, WS_ACT), DFFE, 1.f / 32.f};
                pg8::gemm_phase<epi::EpiSwiGLU<true>, pg8::GroupedOrder, false, PG8_SP2, 1>(F.lds, g, S, E, F.wave);
            }
            SEAM(pb + 9);
            if (ON(17) && IN(pb + 10)) {
                pg8::Gemm g{wsp<bf16>(F, WS_ACT), wsp<bf16>(F, WS_WDNE), 0, 1024, DFFE / 2, (size_t)1024 * DFFE}; pg8::GroupedOrder S; S.init_main(gcnt, 1024, F.G, bidx);
                epi::EpiBf16Split E{wsp<bf16>(F, WS_YBUF), wsp<bf16>(F, WS_YBUF), 1024, 4, 1.f / 256.f};
                pg8::gemm_phase<epi::EpiBf16Split, pg8::GroupedOrder, false, PG8_SP2, 1, false>(F.lds, g, S, E, F.wave);
                { const int tm = pg8::GroupedOrder::main_tiles(S.ts[8], 4, F.G); const int nsub = (S.ts[8] - tm) * 4 * pg8::GroupedOrder::KSPL;
                  pg8::SingleOrder S1; S1.has = bidx < nsub; const int ks = bidx % pg8::GroupedOrder::KSPL, un = bidx / pg8::GroupedOrder::KSPL;
                  S1.u.pm = tm + (un >> 2); S1.u.pn = un & 3; S1.u.e = S.expert_of(S1.u.pm);
                  constexpr int KSL = DFFE / pg8::GroupedOrder::KSPL;
                  pg8::Gemm g1{(const bf16*)(wsp<unsigned char>(F, WS_ACT) + ks * KSL), (const bf16*)(wsp<unsigned char>(F, WS_WDNE) + ks * KSL), 0, 1024, KSL / 2, (size_t)1024 * DFFE, DFFE / 2};
                  bf16* yp = wsp<bf16>(F, WS_YPART) + ((size_t)ks * YPART_ROWS - (size_t)tm * 256) * 1024;
                  epi::EpiBf16Split E1{yp, yp, 1024, 4, 1.f / 256.f};
                  pg8::gemm_phase<epi::EpiBf16Split, pg8::SingleOrder, false, PG8_SP2, 1, false>(F.lds, g1, S1, E1, F.wave); }
            }
            SEAM(pb + 10);
            if (ON(18) && IN(pb + 11)) phase_combine(F, gcnt, ROUTE, F.out);
        }
    }
#undef IN
#undef SEAM
}

__global__ void dbg_dump_bf16(const bf16* src, int ld, int c0, int ncols, float* out, int dc0) {
    const size_t n = (size_t)MTOK * ncols;
    for (size_t i = (size_t)blockIdx.x * blockDim.x + threadIdx.x; i < n; i += (size_t)gridDim.x * blockDim.x) { const size_t m = i / ncols; const int c = (int)(i % ncols);
        out[m * 1024 + dc0 + c] = bf2f(src[m * ld + c0 + c]); }
}
extern "C" void kernel_launch(void* const* d_in, const int* in_sizes, int n_in, void* d_out, int out_size, void* d_ws, size_t ws_size, hipStream_t stream) {
    static int grid = 0;
    if (grid == 0) {
        if (n_in != N_IN || out_size != MTOK * DM || ws_size < WS_END) { fprintf(stderr, "kernel_launch: unexpected shapes: n_in %d out %d ws %zu (need %zu)\n", n_in, out_size, ws_size, (size_t)WS_END); grid = -1; return; }
        int dev = 0, cus = 0, per_cu = 0;
        if (hipGetDevice(&dev) != hipSuccess || hipDeviceGetAttribute(&cus, hipDeviceAttributeMultiprocessorCount, dev) != hipSuccess) { grid = -1; return; }
        if (hipFuncSetAttribute((const void*)mega_fwd, hipFuncAttributeMaxDynamicSharedMemorySize, LDS_BYTES) != hipSuccess) { fprintf(stderr, "kernel_launch: hipFuncSetAttribute failed\n"); grid = -1; return; }
        if (hipOccupancyMaxActiveBlocksPerMultiprocessor(&per_cu, (const void*)mega_fwd, 512, LDS_BYTES) != hipSuccess || per_cu < 1) fprintf(stderr, "kernel_launch: occupancy query says %d\n", per_cu);
        (void)hipGetLastError();
        grid = cus;
    }
    if (grid < 0) return;
    (void)hipMemsetAsync((char*)d_ws + WS_CTL, 0, CTL_ZERO_BYTES, stream);
    Args a{};
    for (int i = 0; i < N_IN; ++i) a.in[i] = (const float*)d_in[i];
    a.out = (float*)d_out; a.ws = (unsigned char*)d_ws;
#if MK_ONE_LAUNCH
    a.ph_lo = 0; a.ph_hi = N_PHASES;
    hipLaunchKernelGGL(mega_fwd, dim3(grid), dim3(512), LDS_BYTES, stream, a);
#else
#ifndef DBG_LAST
#define DBG_LAST N_PHASES
#endif
    for (int ph = 0; ph < DBG_LAST; ++ph) {
        if (ph == 1 + 8 || ph == 2 || ph == 14) continue;
        a.ph_lo = ph; a.ph_hi = ph + 1;
        hipLaunchKernelGGL(mega_fwd, dim3(grid), dim3(512), LDS_BYTES, stream, a);
    }
#ifdef DBG_DUMP
    { unsigned char* ws = (unsigned char*)d_ws; DBG_DUMP }
#endif
#endif
}
```

```cpp
#include <hip/hip_runtime.h>
#include <cstdio>
#include <cstdint>

#ifndef PG8_SP2
#define PG8_SP2 true
#endif
#ifndef DBG_REP_SB
#define DBG_REP_SB 1
#endif
#ifndef L1_INPROJ_FP8
#define L1_INPROJ_FP8 0
#endif
#ifndef MK_ONE_LAUNCH
#define MK_ONE_LAUNCH 1
#endif

constexpr int DM = 1024, BATCH = 4, SEQ = 4096, MTOK = BATCH * SEQ, MEMLEN = 256, MMEM = BATCH * MEMLEN;
constexpr int IN_W = 6672, IN_WP = 6912;
constexpr int DFF = 2816, NEXP = 8, DFFE = 3584;
constexpr float EPS = 1e-6f;
constexpr float LOG2E = 1.4426950408889634f;
constexpr int MOE_ROWS = 2 * MTOK + NEXP * 256;

constexpr size_t MiB = 1u << 20;
constexpr size_t WS_CTL = 0, CTL_ZERO_BYTES = 1 * MiB;
constexpr size_t WS_WIN = 2 * MiB;
constexpr size_t WS_WMKV = WS_WIN + 27 * MiB;
constexpr size_t WS_WBR = WS_WMKV + 4 * MiB;
constexpr size_t WS_WOUT = WS_WBR + 6 * MiB;
constexpr size_t WS_WGU0 = WS_WOUT + 4 * MiB;
constexpr size_t WS_WDN0 = WS_WGU0 + 11 * MiB;
constexpr size_t WS_WGUE = WS_WDN0 + 6 * MiB;
constexpr size_t WS_WDNE = WS_WGUE + 112 * MiB;
constexpr size_t WS_HBUF = WS_WDNE + 56 * MiB;
constexpr size_t WS_HMEM = WS_HBUF + 32 * MiB;
constexpr size_t WS_MK = WS_HMEM + 4 * MiB;
constexpr size_t WS_MV = WS_MK + 2 * MiB;
constexpr size_t WS_ROUTE = WS_MV + 2 * MiB;
constexpr size_t WS_ASORT = WS_ROUTE + 1 * MiB;
constexpr size_t WS_YPART = WS_ASORT;
constexpr int YPART_ROWS = 2560;
constexpr size_t WS_YBUF = WS_ASORT + 68 * MiB;
constexpr size_t WS_HB8 = WS_YBUF + 76 * MiB;
constexpr size_t WS_ACT0 = WS_HB8 + 16 * MiB;
constexpr size_t WS_SBQ = WS_ACT0;
constexpr size_t WS_SBK = WS_SBQ + 16 * MiB;
constexpr size_t WS_SBV = WS_SBK + 16 * MiB;
constexpr size_t WS_GQ = WS_SBV + 16 * MiB;
constexpr size_t WS_GK = WS_GQ + 8 * MiB;
constexpr size_t WS_GV = WS_GK + 8 * MiB;
constexpr size_t WS_LOGA = WS_GV + 16 * MiB;
constexpr size_t WS_GR = WS_LOGA + 16 * MiB;
constexpr size_t WS_CAQ = WS_GR + 16 * MiB;
constexpr size_t WS_GATES = WS_CAQ + 16 * MiB;
constexpr size_t WS_OCAT = WS_GATES + 96 * MiB;
constexpr size_t WS_KV = WS_OCAT + 48 * MiB;
constexpr size_t WS_DEC = WS_KV + 32 * MiB;
constexpr size_t WS_STATE = WS_DEC + 1 * MiB;
constexpr size_t WS_MERGED = WS_STATE + 16 * MiB;
constexpr size_t WS_MIX_END = WS_MERGED + 36 * MiB;
constexpr size_t WS_ACT = WS_ACT0;
constexpr size_t WS_XB = WS_MIX_END;
constexpr int MGP = 1024 + 64, YBP = 1024, GTP = 3072;
constexpr int XBP = 1024 + 64;
constexpr size_t WS_END = WS_XB + 36 * MiB;
static_assert(WS_ACT + (size_t)MOE_ROWS * DFFE * 2 <= WS_END, "MoE act fits the overlay");
static_assert(WS_END <= 896 * MiB, "d_ws budget");

constexpr int CW_TMO = 0;
constexpr int CW_BAR = 4096;
constexpr int CW_PTICK = 49152;
constexpr int CW_CNT = 32768;

constexpr int RING_BYTES = 131072;
constexpr int LDSCTL_OFF = RING_BYTES, MISC_OFF = LDSCTL_OFF + 320;
constexpr int XS_OFF = RING_BYTES + 1024;
constexpr int LDS_BYTES = 147456;

#define GAS __attribute__((address_space(1)))
#define LAS __attribute__((address_space(3)))
typedef unsigned short bf16;
typedef unsigned v4u __attribute__((ext_vector_type(4)));
typedef unsigned v2u __attribute__((ext_vector_type(2)));
typedef float f32x4 __attribute__((ext_vector_type(4)));
typedef float f32x16 __attribute__((ext_vector_type(16)));
typedef short bf16x8 __attribute__((ext_vector_type(8)));
typedef short s16x4 __attribute__((ext_vector_type(4)));
typedef GAS unsigned gu32;
#define RLX_AGENT __ATOMIC_RELAXED, __HIP_MEMORY_SCOPE_AGENT
#define LDS_WAIT() asm volatile("s_waitcnt lgkmcnt(0)" ::: "memory")
#define VM_WAIT() asm volatile("s_waitcnt vmcnt(0)" ::: "memory")

__device__ __forceinline__ unsigned f2bf(float f) { unsigned u = __builtin_bit_cast(unsigned, f); return (u + 0x7fffu + ((u >> 16) & 1u)) >> 16; }
__device__ __forceinline__ unsigned pk2(float lo, float hi) { return f2bf(lo) | (f2bf(hi) << 16); }
__device__ __forceinline__ float bf2f(unsigned short b) { return __builtin_bit_cast(float, (unsigned)b << 16); }
__device__ __forceinline__ float bflo(unsigned w) { return __builtin_bit_cast(float, w << 16); }
__device__ __forceinline__ float bfhi(unsigned w) { return __builtin_bit_cast(float, w & 0xffff0000u); }
typedef float f32x2_t __attribute__((ext_vector_type(2))); typedef __bf16 bf16x2_t __attribute__((ext_vector_type(2)));
__device__ __forceinline__ unsigned cvt_pk_bf16(float lo, float hi) { f32x2_t v = {lo, hi}; bf16x2_t b = __builtin_convertvector(v, bf16x2_t); return __builtin_bit_cast(unsigned, b); }
__device__ __forceinline__ unsigned pk4_fp8(float a, float b, float c, float d) {
    a = __builtin_amdgcn_fmed3f(a, -448.f, 448.f); b = __builtin_amdgcn_fmed3f(b, -448.f, 448.f); c = __builtin_amdgcn_fmed3f(c, -448.f, 448.f); d = __builtin_amdgcn_fmed3f(d, -448.f, 448.f);
    int r = __builtin_amdgcn_cvt_pk_fp8_f32(a, b, 0, false); r = __builtin_amdgcn_cvt_pk_fp8_f32(c, d, r, true); return (unsigned)r; }
__device__ __forceinline__ float ex2(float x) { return __builtin_amdgcn_exp2f(x); }
__device__ __forceinline__ float lg2(float x) { return __builtin_amdgcn_logf(x); }
__device__ __forceinline__ float rcpf_(float x) { return __builtin_amdgcn_rcpf(x); }
__device__ __forceinline__ float sigmoidf_(float x) { return rcpf_(1.f + ex2(-x * LOG2E)); }
__device__ __forceinline__ int lane_fresh() { unsigned m = ~0u; asm volatile("" : "+s"(m)); return (int)__builtin_amdgcn_mbcnt_hi(m, __builtin_amdgcn_mbcnt_lo(m, 0u)); }
template <int K> __device__ __forceinline__ float swz_xor(float x) { return __int_as_float(__builtin_amdgcn_ds_swizzle(__float_as_int(x), (K << 10) | 0x1f)); }
__device__ __forceinline__ float other_half(float x, int hi) { const auto rr = __builtin_amdgcn_permlane32_swap(__float_as_uint(x), __float_as_uint(x), false, false); return __uint_as_float(hi ? rr[0] : rr[1]); }
__device__ __forceinline__ float wave_sum(float v, int hi) {
    v += swz_xor<1>(v); v += swz_xor<2>(v); v += swz_xor<4>(v); v += swz_xor<8>(v); v += swz_xor<16>(v); v += other_half(v, hi); return v;
}
__device__ __forceinline__ int crow(int r, int hi) { return (r & 3) + 8 * (r >> 2) + 4 * hi; }

template <bool XBF> __device__ __forceinline__ f32x4 ldx4(const void* row, int idx) {
    if constexpr (XBF) { const v2u w = *((const GAS v2u*)row + idx); return (f32x4){bflo(w.x), bfhi(w.x), bflo(w.y), bfhi(w.y)}; }
    else return *((const GAS f32x4*)row + idx);
}
namespace pg8 {
#define PG8_LAS __attribute__((address_space(3)))
typedef unsigned short bf16_t;
constexpr int BM = 256, BK = 64, HALF = 128, HTB = HALF * BK * 2, STAGE_BYTES = 8 * HTB, NXCD = 8, WGM = 4;
__host__ __device__ __forceinline__ int lds_byte(int r, int c) { const int st = (r >> 4) * 2 + (c >> 5), rr = r & 15, cc = c & 31, ob = rr * 64 + cc * 2; return st * 1024 + (ob ^ (((ob >> 9) & 1) << 5)); }
__host__ __device__ __forceinline__ void stage_rc(int b, int& R, int& C) { const int st = b / 1024, sb = b % 1024, swz = sb ^ (((sb >> 9) & 1) << 5); R = (st >> 1) * 16 + swz / 64; C = (st & 1) * 32 + (swz % 64) / 2; }
__host__ __device__ __forceinline__ int perm32(int rho) { const int n = rho >> 4, i = rho & 15; return 8 * (i >> 2) + 4 * n + (i & 3); }

struct Unit { int pm, pn, e; };
struct Gemm { const bf16_t* A; const bf16_t* Bt; int M, N, K; size_t bgs; int KP; int KPB; };

struct StaticOrder {
    int nM, nN, nwg, G, c;
    __host__ __device__ void init(int M, int N, int G_, int c_) { nM = M / BM; nN = N / BM; nwg = nM * nN; G = G_; c = c_; }
    __host__ __device__ bool next(int i, Unit& u) const {
        const long L = (long)i * G + c; if (L >= nwg) return false;
        int wgid = (int)L; { const int q = nwg / NXCD, r = nwg % NXCD, xcd = wgid % NXCD, off = wgid / NXCD; wgid = (xcd < r ? xcd * (q + 1) : r * (q + 1) + (xcd - r) * q) + off; }
        const int nig = WGM * nN, gid = wgid / nig, fm = gid * WGM, gsz = (nM - fm) < WGM ? (nM - fm) : WGM;
        u.pm = fm + ((wgid % nig) % gsz); u.pn = (wgid % nig) / gsz; u.e = 0; return true;
    }
};
struct GroupedOrder {
    StaticOrder so; int ts[9];
    __device__ void init(const unsigned* cnt, int N, int G_, int c_) {
        int t = 0;
#pragma unroll
        for (int e = 0; e < 8; ++e) { ts[e] = t; t += ((int)cnt[e * 64] + 255) >> 8; }
        ts[8] = t; so.init(t * BM, N, G_, c_);
    }
    static constexpr int KSPL = 7;
    __device__ static int main_tiles(int t, int nN, int G_) { const int tm = ((t * nN) / G_) * G_ / nN; return ((t - tm) * nN * KSPL <= G_) ? tm : t; }
    __device__ void init_main(const unsigned* cnt, int N, int G_, int c_) { init(cnt, N, G_, c_); so.init(main_tiles(ts[8], N / BM, G_) * BM, N, G_, c_); }
    __device__ int expert_of(int pm) const { int e = 0;
#pragma unroll
        for (int k = 1; k < 8; ++k) e = (pm >= ts[k]) ? k : e;
        return __builtin_amdgcn_readfirstlane(e); }
    __device__ bool next(int i, Unit& u) const {
        if (!so.next(i, u)) return false;
        int e = 0;
#pragma unroll
        for (int k = 1; k < 8; ++k) e = (u.pm >= ts[k]) ? k : e;
        u.e = __builtin_amdgcn_readfirstlane(e); return true;
    }
};

struct SingleOrder { Unit u; bool has; __device__ bool next(int i, Unit& o) const { if (i == 0 && has) { o = u; return true; } return false; } };
typedef float f32x2 __attribute__((ext_vector_type(2)));

template <class Epi, class Sched, bool ALIGN_EPI = false, bool SP2 = false, int FP8SC = 0>
__device__ __forceinline__ void gemm_phase(PG8_LAS unsigned char* lds, const Gemm g, const Sched& S, const Epi& E, const int wid_  ) {
    int wid = wid_; asm volatile("" : "+s"(wid));
    const int wr = wid >> 2, wc = wid & 3;
    const int K = g.K, nt = K / BK, KP = g.KP ? g.KP : K, KPB = g.KPB ? g.KPB : K;
    unsigned voffA[2], voffB[2]; int aoff, boff;
#define PG8_ADDR() do { const int lane = lane_fresh(), tid = wid * 64 + lane, fr = lane & 15, fq = lane >> 4; \
    _Pragma("unroll") for (int i = 0; i < 2; ++i) { int R, C; stage_rc(tid * 16 + i * 8192, R, C); const int Rb = Epi::PERM ? ((R & ~31) + perm32(R & 31)) : R; \
        voffA[i] = (unsigned)(R * KP + C) * 2u; voffB[i] = (unsigned)(Rb * KPB + C) * 2u; } \
    aoff = lds_byte(wr * 64 + fr, fq * 8); boff = lds_byte(wc * 32 + fr, fq * 8); } while (0)
    PG8_ADDR();
    const size_t kstep = (size_t)(BK * 2);
    const size_t hstep = (size_t)HALF * KP * 2, hstepB = (size_t)HALF * KPB * 2;
    const size_t tstep = 2 * hstep, tstepB = 2 * hstepB;
    const unsigned ldsw = (unsigned)wid * 1024u;
#define PG8_SA(b, h) (((b) * 2 + (h)) * HTB)
#define PG8_SB(b, h) ((4 + (b) * 2 + (h)) * HTB)
#define PG8_STAGE(bufoff, gbase, voff) do { _Pragma("unroll") for (int _i = 0; _i < 2; ++_i) { unsigned _vo = (voff)[_i]; asm volatile("" : "+v"(_vo));   \
        __builtin_amdgcn_global_load_lds((const unsigned*)((const char*)(gbase) + _vo), (PG8_LAS unsigned*)(lds + (bufoff) + ldsw + _i * 8192), 16, 0, 0); } } while (0)
#define PG8_LDA(dst, b, h) do { _Pragma("unroll") for (int m = 0; m < 4; ++m) _Pragma("unroll") for (int k = 0; k < 2; ++k) dst[m][k] = *(const PG8_LAS bf16x8*)(lds + PG8_SA(b, h) + aoff + m * 2048 + k * 1024); } while (0)
#define PG8_LDB(dst, b, h) do { _Pragma("unroll") for (int n = 0; n < 2; ++n) _Pragma("unroll") for (int k = 0; k < 2; ++k) dst[n][k] = *(const PG8_LAS bf16x8*)(lds + PG8_SB(b, h) + boff + n * 2048 + k * 1024); } while (0)
#define PG8_MMA(ai, bj, At, Bt) do { __builtin_amdgcn_s_setprio(1); _Pragma("unroll") for (int m = 0; m < 4; ++m) _Pragma("unroll") for (int n = 0; n < 2; ++n) { \
        if constexpr (FP8SC != 0) { typedef int v4i_ __attribute__((ext_vector_type(4))); typedef int v8i_ __attribute__((ext_vector_type(8))); \
            const v4i_ w0 = __builtin_bit_cast(v4i_, Bt[n][0]), w1 = __builtin_bit_cast(v4i_, Bt[n][1]), x0 = __builtin_bit_cast(v4i_, At[m][0]), x1 = __builtin_bit_cast(v4i_, At[m][1]); \
            acc[ai][bj][m][n] = __builtin_amdgcn_mfma_scale_f32_16x16x128_f8f6f4((v8i_){w0.x, w0.y, w0.z, w0.w, w1.x, w1.y, w1.z, w1.w}, (v8i_){x0.x, x0.y, x0.z, x0.w, x1.x, x1.y, x1.z, x1.w}, acc[ai][bj][m][n], 0, 0, 0, 0, 0, 0); } \
        else { _Pragma("unroll") for (int k = 0; k < 2; ++k) acc[ai][bj][m][n] = __builtin_amdgcn_mfma_f32_16x16x32_bf16(Bt[n][k], At[m][k], acc[ai][bj][m][n], 0, 0, 0); } } \
        __builtin_amdgcn_s_setprio(0); } while (0)
#define PG8_WAIT_V(n) asm volatile("s_waitcnt vmcnt(" #n ")" ::: "memory")
#define PG8_WAIT_L(n) asm volatile("s_waitcnt lgkmcnt(" #n ")" ::: "memory")
#define PG8_WAIT_VB(rel) do { if (rel) asm volatile("s_waitcnt vmcnt(%0)" :: "n"(8 + Epi::NST) : "memory"); else asm volatile("s_waitcnt vmcnt(8)" ::: "memory"); } while (0)
#define PG8_BAR __builtin_amdgcn_s_barrier()
#define PG8_SCHED __builtin_amdgcn_sched_barrier(0)
    Unit cur, nxt; int ui = 0;
    if (!S.next(0, cur)) return;
    f32x4 acc[2][2][4][2];
#pragma unroll
    for (int a = 0; a < 2; ++a)
#pragma unroll
        for (int b = 0; b < 2; ++b)
#pragma unroll
            for (int m = 0; m < 4; ++m)
#pragma unroll
                for (int n = 0; n < 2; ++n) acc[a][b][m][n] = (f32x4){0.f, 0.f, 0.f, 0.f};
    bf16x8 At[4][2], B0[2][2], B1[2][2];
    const char* cA = (const char*)g.A + (size_t)cur.pm * tstep; const char* cB = (const char*)g.Bt + (size_t)cur.e * g.bgs + (size_t)cur.pn * tstepB;
    if constexpr (SP2) {
        PG8_STAGE(PG8_SB(0, 0), cB, voffB); PG8_STAGE(PG8_SB(0, 1), cB + hstepB, voffB); PG8_STAGE(PG8_SA(0, 0), cA, voffA); PG8_STAGE(PG8_SA(0, 1), cA + hstep, voffA);
        if (wr == 1) PG8_BAR;
        PG8_WAIT_V(2); PG8_BAR;
        PG8_STAGE(PG8_SB(1, 0), cB + kstep, voffB); PG8_STAGE(PG8_SA(1, 0), cA + kstep, voffA); PG8_STAGE(PG8_SB(1, 1), cB + hstepB + kstep, voffB);
        PG8_WAIT_V(6); PG8_BAR;
    } else {
        PG8_STAGE(PG8_SB(0, 0), cB, voffB); PG8_STAGE(PG8_SA(0, 0), cA, voffA); PG8_STAGE(PG8_SB(0, 1), cB + hstepB, voffB); PG8_STAGE(PG8_SA(0, 1), cA + hstep, voffA);
        if (wr == 1) PG8_BAR;
        PG8_WAIT_V(4); PG8_BAR;
        PG8_STAGE(PG8_SB(1, 0), cB + kstep, voffB); PG8_STAGE(PG8_SA(1, 0), cA + kstep, voffA); PG8_STAGE(PG8_SB(1, 1), cB + hstepB + kstep, voffB);
        PG8_WAIT_V(6); PG8_BAR;
    }
    for (;;) {
        const bool has_next = S.next(ui + 1, nxt);
        const char* nA = has_next ? (const char*)g.A + (size_t)nxt.pm * tstep : cA; const char* nB = has_next ? (const char*)g.Bt + (size_t)nxt.e * g.bgs + (size_t)nxt.pn * tstepB : cB;
        for (int t = 0; t < nt; t += 2) {
            if constexpr (Epi::KHOOK) { if (t == 8 || t == 16) E.khook(acc, cur, t >> 3, wr, wc); }
            const bool last = (t == nt - 2);
            const char* a1 = cA + (size_t)(t + 1) * kstep;
            const char* a2 = last ? nA : cA + (size_t)(t + 2) * kstep; const char* b2 = last ? nB : cB + (size_t)(t + 2) * kstep;
            const char* a3 = a2 + kstep; const char* b3 = b2 + kstep;
            if constexpr (SP2) {
            const bool rel = (t == 0) && (ui > 0);
            PG8_LDB(B0, 0, 0); PG8_LDB(B1, 0, 1); PG8_SCHED; PG8_LDA(At, 0, 0); if (!rel) PG8_STAGE(PG8_SA(1, 1), a1 + hstep, voffA);
            PG8_WAIT_VB(rel); PG8_WAIT_L(0); PG8_BAR; PG8_MMA(0, 0, At, B0); PG8_MMA(0, 1, At, B1); PG8_BAR; PG8_SCHED;
            PG8_LDA(At, 0, 1); PG8_STAGE(PG8_SB(0, 0), b2, voffB); PG8_STAGE(PG8_SB(0, 1), b2 + hstepB, voffB); PG8_STAGE(PG8_SA(0, 0), a2, voffA);
            PG8_WAIT_VB(rel); PG8_WAIT_L(0); PG8_BAR; PG8_MMA(1, 0, At, B0); PG8_MMA(1, 1, At, B1); PG8_BAR; PG8_SCHED;
            PG8_LDB(B0, 1, 0); PG8_LDB(B1, 1, 1); PG8_SCHED; PG8_LDA(At, 1, 0); PG8_STAGE(PG8_SA(0, 1), a2 + hstep, voffA);
            PG8_WAIT_VB(rel); PG8_WAIT_L(0); PG8_BAR; PG8_MMA(0, 0, At, B0); PG8_MMA(0, 1, At, B1); PG8_BAR; PG8_SCHED;
            PG8_LDA(At, 1, 1); PG8_STAGE(PG8_SB(1, 0), b3, voffB); PG8_STAGE(PG8_SB(1, 1), b3 + hstepB, voffB); PG8_STAGE(PG8_SA(1, 0), a3, voffA);
            PG8_WAIT_V(8); PG8_WAIT_L(0); PG8_BAR; PG8_MMA(1, 0, At, B0); PG8_MMA(1, 1, At, B1); PG8_BAR; PG8_SCHED;
            } else {
            PG8_LDB(B0, 0, 0); PG8_SCHED; PG8_LDA(At, 0, 0); PG8_STAGE(PG8_SA(1, 1), a1 + hstep, voffA);
            PG8_WAIT_L(8); PG8_BAR; PG8_WAIT_L(0); PG8_MMA(0, 0, At, B0); PG8_BAR; PG8_SCHED;
            PG8_LDB(B1, 0, 1); PG8_STAGE(PG8_SB(0, 0), b2, voffB);
            PG8_BAR; PG8_WAIT_L(0); PG8_MMA(0, 1, At, B1); PG8_BAR;
            PG8_LDA(At, 0, 1); PG8_STAGE(PG8_SA(0, 0), a2, voffA);
            PG8_BAR; PG8_WAIT_L(0); PG8_MMA(1, 0, At, B0); PG8_BAR; PG8_SCHED;
            PG8_STAGE(PG8_SB(0, 1), b2 + hstepB, voffB);
            PG8_WAIT_V(6); PG8_BAR; PG8_MMA(1, 1, At, B1); PG8_BAR;
            PG8_LDB(B0, 1, 0); PG8_SCHED; PG8_LDA(At, 1, 0); PG8_STAGE(PG8_SA(0, 1), a2 + hstep, voffA);
            PG8_WAIT_L(8); PG8_BAR; PG8_WAIT_L(0); PG8_MMA(0, 0, At, B0); PG8_BAR; PG8_SCHED;
            PG8_LDB(B1, 1, 1); PG8_STAGE(PG8_SB(1, 0), b3, voffB);
            PG8_BAR; PG8_WAIT_L(0); PG8_MMA(0, 1, At, B1); PG8_BAR;
            PG8_LDA(At, 1, 1); PG8_STAGE(PG8_SA(1, 0), a3, voffA);
            PG8_BAR; PG8_WAIT_L(0); PG8_MMA(1, 0, At, B0); PG8_BAR; PG8_SCHED;
            PG8_STAGE(PG8_SB(1, 1), b3 + hstepB, voffB);
            PG8_WAIT_V(6); PG8_BAR; PG8_MMA(1, 1, At, B1); PG8_BAR;
            }
        }
        if constexpr (SP2) PG8_STAGE(PG8_SA(1, 1), nA + kstep + hstep, voffA);
        if constexpr (ALIGN_EPI) { if (wr == 0) PG8_BAR; }
        E(acc, cur, wr, wc);
        if (!has_next) break;
        PG8_ADDR();
#pragma unroll
        for (int a = 0; a < 2; ++a)
#pragma unroll
            for (int b = 0; b < 2; ++b)
#pragma unroll
                for (int m = 0; m < 4; ++m)
#pragma unroll
                    for (int n = 0; n < 2; ++n) acc[a][b][m][n] = (f32x4){0.f, 0.f, 0.f, 0.f};
        cur = nxt; cA = nA; cB = nB; ++ui;
        if constexpr (ALIGN_EPI) { if (wr == 1) PG8_BAR; }
    }
    PG8_WAIT_V(0);
    if constexpr (!ALIGN_EPI) { if (wr == 0) PG8_BAR; }
    PG8_BAR;
#undef PG8_ADDR
#undef PG8_SA
#undef PG8_SB
#undef PG8_STAGE
#undef PG8_LDA
#undef PG8_LDB
#undef PG8_MMA
#undef PG8_WAIT_V
#undef PG8_WAIT_L
#undef PG8_WAIT_VB
#undef PG8_BAR
#undef PG8_SCHED
}
}

constexpr float ACT_SCALE = 4.f;
namespace epi {
using pg8::Unit; using pg8::BM; using pg8::HALF;
typedef float f32x4 __attribute__((ext_vector_type(4)));
typedef unsigned u32x4 __attribute__((ext_vector_type(4)));
#define EPI_FOR_ALL(ai, m, bj) _Pragma("unroll") for (int ai = 0; ai < 2; ++ai) _Pragma("unroll") for (int m = 0; m < 4; ++m) _Pragma("unroll") for (int bj = 0; bj < 2; ++bj)

typedef float f32x2 __attribute__((ext_vector_type(2)));
__device__ __forceinline__ f32x2 lo2(f32x4 v) { return __builtin_shufflevector(v, v, 0, 1); }
__device__ __forceinline__ f32x2 hi2(f32x4 v) { return __builtin_shufflevector(v, v, 2, 3); }
__device__ __forceinline__ f32x2 ex2_2(f32x2 x) { return (f32x2){ex2(x.x), ex2(x.y)}; }
__device__ __forceinline__ f32x2 rcp_2(f32x2 x) { return (f32x2){rcpf_(x.x), rcpf_(x.y)}; }
__device__ __forceinline__ u32x4 pack8(f32x4 v0, f32x4 v1) { u32x4 w; w.x = cvt_pk_bf16(v0[0], v0[1]); w.y = cvt_pk_bf16(v0[2], v0[3]); w.z = cvt_pk_bf16(v1[0], v1[1]); w.w = cvt_pk_bf16(v1[2], v1[3]); return w; }

struct EpiInProj {
    static constexpr bool PERM = true, KHOOK = false; static constexpr int NST = 16;
    bf16 *sbq, *sbk, *sbv, *gq, *gk, *gv, *gr, *caq, *gates; float* loga; const float* ga_b; float sc;
    __device__ __forceinline__ void operator()(const f32x4 (&acc)[2][2][4][2], const Unit& u, int wr, int wc) const {
        const int lane_ = lane_fresh(), fr = lane_ & 15, fq = lane_ >> 4;
        const int pn = u.pn; const int row0 = u.pm * BM + wr * 64 + fr; const int cw = wc * 32 + 8 * fq;
        bf16* base; int ldc, colt, act = 0;
        if (pn < 2) { base = sbq; ldc = 512; colt = pn * 256; }
        else if (pn < 4) { base = sbk; ldc = 512; colt = (pn - 2) * 256; }
        else if (pn < 6) { base = sbv; ldc = 512; colt = (pn - 4) * 256; }
        else if (pn == 6) { base = gq; ldc = 256; colt = 0; }
        else if (pn == 7) { base = gk; ldc = 256; colt = 0; }
        else if (pn < 10) { base = gv; ldc = 512; colt = (pn - 8) * 256; }
        else if (pn == 10) { base = nullptr; ldc = 256; colt = 0; act = 3; }
        else if (pn < 13) { base = gr; ldc = 512; colt = (pn - 11) * 256; act = 2; }
        else { base = caq; ldc = 512; colt = (pn - 13) * 256; }
        if (act == 3) {
            EPI_FOR_ALL(ai, m, bj) { const int row = row0 + ai * HALF + m * 16, col = cw + bj * HALF;
                f32x4 b0 = *(const GAS f32x4*)(ga_b + col), b1 = *(const GAS f32x4*)(ga_b + col + 4), o0, o1;
#pragma unroll
                for (int j = 0; j < 4; ++j) { float x = acc[ai][bj][m][0][j] * sc + b0[j]; float y = acc[ai][bj][m][1][j] * sc + b1[j];
                    o0[j] = -(fmaxf(-x, 0.f) + lg2(1.f + ex2(-fabsf(x) * LOG2E)) * 0.6931471805599453f) * 0.0625f;
                    o1[j] = -(fmaxf(-y, 0.f) + lg2(1.f + ex2(-fabsf(y) * LOG2E)) * 0.6931471805599453f) * 0.0625f; }
                float* p = loga + (size_t)row * 256 + col; *(f32x4*)p = o0; *(GAS f32x4*)(p + 4) = o1; }
            return;
        }
        EPI_FOR_ALL(ai, m, bj) { const int row = row0 + ai * HALF + m * 16, col = colt + cw + bj * HALF;
            f32x4 v0 = acc[ai][bj][m][0] * sc, v1 = acc[ai][bj][m][1] * sc;
            if (act == 2) {
#pragma unroll
                for (int j = 0; j < 4; ++j) { v0[j] = v0[j] * sigmoidf_(v0[j]); v1[j] = v1[j] * sigmoidf_(v1[j]); } }
            *(GAS u32x4*)(base + (size_t)row * ldc + col) = pack8(v0, v1); }
    }
};

__device__ __forceinline__ unsigned gate_u8x4(float a, float b, float c, float d) {
    unsigned w = 0u;
    w = __builtin_amdgcn_cvt_pk_u8_f32(__builtin_fmaf(a, 255.f, 0.5f), 0u, w); w = __builtin_amdgcn_cvt_pk_u8_f32(__builtin_fmaf(b, 255.f, 0.5f), 1u, w);
    w = __builtin_amdgcn_cvt_pk_u8_f32(__builtin_fmaf(c, 255.f, 0.5f), 2u, w); w = __builtin_amdgcn_cvt_pk_u8_f32(__builtin_fmaf(d, 255.f, 0.5f), 3u, w); return w; }
template <int J> __device__ __forceinline__ float gate_f(unsigned w) { return fmaxf((float)((w >> (8 * J)) & 0xffu), 1.f); }
struct EpiGates {
    static constexpr bool PERM = true, KHOOK = false; static constexpr int NST = 16;
    bf16* gates; float sc;
    __device__ __forceinline__ void operator()(const f32x4 (&acc)[2][2][4][2], const Unit& u, int wr, int wc) const {
        const int lane_ = lane_fresh(), fr = lane_ & 15, fq = lane_ >> 4;
        const int row0 = u.pm * BM + wr * 64 + fr; const int c0 = u.pn * BM + wc * 32 + 8 * fq; const float nsc = -sc * LOG2E;
        EPI_FOR_ALL(ai, m, bj) { f32x2 r[4];
#pragma unroll
            for (int q = 0; q < 4; ++q) { const f32x2 a = (q & 1) ? hi2(acc[ai][bj][m][q >> 1]) : lo2(acc[ai][bj][m][q >> 1]); r[q] = a * nsc; }
            __builtin_amdgcn_sched_barrier(0);
#pragma unroll
            for (int q = 0; q < 4; ++q) r[q] = ex2_2(r[q]);
            __builtin_amdgcn_sched_barrier(0);
#pragma unroll
            for (int q = 0; q < 4; ++q) r[q] = r[q] + 1.f;
            __builtin_amdgcn_sched_barrier(0);
#pragma unroll
            for (int q = 0; q < 4; ++q) r[q] = rcp_2(r[q]);
            __builtin_amdgcn_sched_barrier(0);
            v2u w; w.x = gate_u8x4(r[0].x, r[0].y, r[1].x, r[1].y); w.y = gate_u8x4(r[2].x, r[2].y, r[3].x, r[3].y);
            *(GAS v2u*)((unsigned char*)gates + (size_t)(row0 + ai * HALF + m * 16) * GTP + c0 + bj * HALF) = w; }
    }
};

struct EpiBf16Split {
    static constexpr bool PERM = true, KHOOK = false; static constexpr int NST = 16;
    bf16 *O0, *O1; int ldc, nsplit; float sc;
    __device__ __forceinline__ void operator()(const f32x4 (&acc)[2][2][4][2], const Unit& u, int wr, int wc) const {
        const int lane_ = lane_fresh(), fr = lane_ & 15, fq = lane_ >> 4;
        const int row0 = u.pm * BM + wr * 64 + fr; const int cw = wc * 32 + 8 * fq;
        bf16* base = (u.pn < nsplit) ? O0 : O1; const int colt = ((u.pn < nsplit) ? u.pn : u.pn - nsplit) * 256;
        EPI_FOR_ALL(ai, m, bj) { const int row = row0 + ai * HALF + m * 16, col = colt + cw + bj * HALF;
            *(GAS u32x4*)(base + (size_t)row * ldc + col) = pack8(acc[ai][bj][m][0] * sc, acc[ai][bj][m][1] * sc); }
    }
};

struct EpiBranch {
    static constexpr bool PERM = true, KHOOK = true; static constexpr int NST = 16;
    const bf16* gates; bf16* O;
    __device__ __forceinline__ void khook(f32x4 (&acc)[2][2][4][2], const Unit& u, int s, int wr, int wc) const {
        const int lane_ = lane_fresh(), fr = lane_ & 15, fq = lane_ >> 4;
        int row0 = u.pm * BM + wr * 64 + fr; int c0 = u.pn * BM + wc * 32 + 8 * fq;
        asm volatile("" : "+v"(row0), "+v"(c0));
        const unsigned char* g8 = (const unsigned char*)gates;
#define BR_LOAD(b, gn, gd) do { _Pragma("unroll") for (int mm = 0; mm < 2; ++mm) _Pragma("unroll") for (int bj = 0; bj < 2; ++bj) { \
            const unsigned char* gp = g8 + (size_t)(row0 + ((b) >> 1) * HALF + (2 * ((b) & 1) + mm) * 16) * GTP + c0 + bj * HALF; \
            gn[mm][bj] = *(const GAS v2u*)(gp + (size_t)(s - 1) * 1024); gd[mm][bj] = *(const GAS v2u*)(gp + (size_t)s * 1024); } } while (0)
#define BR_SCALE(b, gn, gd) do { _Pragma("unroll") for (int mm = 0; mm < 2; ++mm) _Pragma("unroll") for (int bj = 0; bj < 2; ++bj) { constexpr int ai = (b) >> 1; const int m = 2 * ((b) & 1) + mm; \
            const unsigned n0 = gn[mm][bj].x, n1 = gn[mm][bj].y, d0 = gd[mm][bj].x, d1 = gd[mm][bj].y; \
            acc[ai][bj][m][0][0] *= gate_f<0>(n0) * rcpf_(gate_f<0>(d0)); acc[ai][bj][m][0][1] *= gate_f<1>(n0) * rcpf_(gate_f<1>(d0)); \
            acc[ai][bj][m][0][2] *= gate_f<2>(n0) * rcpf_(gate_f<2>(d0)); acc[ai][bj][m][0][3] *= gate_f<3>(n0) * rcpf_(gate_f<3>(d0)); \
            acc[ai][bj][m][1][0] *= gate_f<0>(n1) * rcpf_(gate_f<0>(d1)); acc[ai][bj][m][1][1] *= gate_f<1>(n1) * rcpf_(gate_f<1>(d1)); \
            acc[ai][bj][m][1][2] *= gate_f<2>(n1) * rcpf_(gate_f<2>(d1)); acc[ai][bj][m][1][3] *= gate_f<3>(n1) * rcpf_(gate_f<3>(d1)); } } while (0)
        v2u gnA[2][2], gdA[2][2], gnB[2][2], gdB[2][2];
        BR_LOAD(0, gnA, gdA); __builtin_amdgcn_sched_barrier(0);
        BR_LOAD(1, gnB, gdB); __builtin_amdgcn_sched_barrier(0); BR_SCALE(0, gnA, gdA); __builtin_amdgcn_sched_barrier(0);
        BR_LOAD(2, gnA, gdA); __builtin_amdgcn_sched_barrier(0); BR_SCALE(1, gnB, gdB); __builtin_amdgcn_sched_barrier(0);
        BR_LOAD(3, gnB, gdB); __builtin_amdgcn_sched_barrier(0); BR_SCALE(2, gnA, gdA); __builtin_amdgcn_sched_barrier(0);
        BR_SCALE(3, gnB, gdB);
#undef BR_LOAD
#undef BR_SCALE
        asm volatile("" ::: "memory");
    }
    __device__ __forceinline__ void operator()(const f32x4 (&acc)[2][2][4][2], const Unit& u, int wr, int wc) const {
        const int lane_ = lane_fresh(), fr = lane_ & 15, fq = lane_ >> 4;
        const int row0 = u.pm * BM + wr * 64 + fr; const int c0 = u.pn * BM + wc * 32 + 8 * fq;
        EPI_FOR_ALL(ai, m, bj) { const int row = row0 + ai * HALF + m * 16, col = c0 + bj * HALF;
            const v2u g2 = *(const GAS v2u*)((const unsigned char*)gates + (size_t)row * GTP + 2048 + col);
            f32x4 v0 = acc[ai][bj][m][0], v1 = acc[ai][bj][m][1]; const float k = 1.f / 255.f;
            v0[0] *= gate_f<0>(g2.x) * k; v0[1] *= gate_f<1>(g2.x) * k; v0[2] *= gate_f<2>(g2.x) * k; v0[3] *= gate_f<3>(g2.x) * k;
            v1[0] *= gate_f<0>(g2.y) * k; v1[1] *= gate_f<1>(g2.y) * k; v1[2] *= gate_f<2>(g2.y) * k; v1[3] *= gate_f<3>(g2.y) * k;
            *(GAS u32x4*)(O + (size_t)row * MGP + col) = pack8(v0, v1); }
    }
};

struct EpiResF32 {
    static constexpr bool PERM = true, KHOOK = false; static constexpr int NST = 16;
    const void* res; int res_bf16; bf16* out; float sc;
    __device__ __forceinline__ void operator()(const f32x4 (&acc)[2][2][4][2], const Unit& u, int wr, int wc) const {
        const int lane_ = lane_fresh(), fr = lane_ & 15, fq = lane_ >> 4;
        const int row0 = u.pm * BM + wr * 64 + fr; const int c0 = u.pn * BM + wc * 32 + 8 * fq;
        if (res_bf16) {
            EPI_FOR_ALL(ai, m, bj) { const size_t off = (size_t)(row0 + ai * HALF + m * 16) * XBP + c0 + bj * HALF;
                const u32x4 w = *(const GAS u32x4*)((const bf16*)res + off);
                const f32x4 r0 = {bflo(w.x), bfhi(w.x), bflo(w.y), bfhi(w.y)}, r1 = {bflo(w.z), bfhi(w.z), bflo(w.w), bfhi(w.w)};
                *(GAS u32x4*)(out + off) = pack8(r0 + acc[ai][bj][m][0] * sc, r1 + acc[ai][bj][m][1] * sc); }
        } else {
            EPI_FOR_ALL(ai, m, bj) { const size_t off = (size_t)(row0 + ai * HALF + m * 16) * 1024 + c0 + bj * HALF, offo = (size_t)(row0 + ai * HALF + m * 16) * XBP + c0 + bj * HALF;
                const f32x4 r0 = *(const GAS f32x4*)((const float*)res + off), r1 = *(const GAS f32x4*)((const float*)res + off + 4);
                *(GAS u32x4*)(out + offo) = pack8(r0 + acc[ai][bj][m][0] * sc, r1 + acc[ai][bj][m][1] * sc); }
        }
    }
};

template <bool OUT_FP8> struct EpiSwiGLU {
    static constexpr bool PERM = true, KHOOK = false; static constexpr int NST = 8;
    unsigned char* O; int ldc; float sc;
    __device__ __forceinline__ void operator()(const f32x4 (&acc)[2][2][4][2], const Unit& u, int wr, int wc) const {
        const int lane_ = lane_fresh(), fr = lane_ & 15, fq = lane_ >> 4;
        const int row0 = u.pm * BM + wr * 64 + fr; const int c0 = u.pn * HALF + wc * 32 + 8 * fq; const float s2 = OUT_FP8 ? sc * ACT_SCALE : sc; const float c1 = -sc * LOG2E, c2 = sc * s2;
#pragma unroll
        for (int ai = 0; ai < 2; ++ai)
#pragma unroll
            for (int m = 0; m < 4; ++m) { f32x2 v[4];
#pragma unroll
                for (int q = 0; q < 4; ++q) { const f32x2 g = (q & 1) ? hi2(acc[ai][0][m][q >> 1]) : lo2(acc[ai][0][m][q >> 1]); v[q] = g * c1; }
                __builtin_amdgcn_sched_barrier(0);
#pragma unroll
                for (int q = 0; q < 4; ++q) v[q] = ex2_2(v[q]);
                __builtin_amdgcn_sched_barrier(0);
#pragma unroll
                for (int q = 0; q < 4; ++q) v[q] = v[q] + 1.f;
                __builtin_amdgcn_sched_barrier(0);
#pragma unroll
                for (int q = 0; q < 4; ++q) v[q] = rcp_2(v[q]);
                __builtin_amdgcn_sched_barrier(0);
#pragma unroll
                for (int q = 0; q < 4; ++q) { const f32x2 g = (q & 1) ? hi2(acc[ai][0][m][q >> 1]) : lo2(acc[ai][0][m][q >> 1]), u = (q & 1) ? hi2(acc[ai][1][m][q >> 1]) : lo2(acc[ai][1][m][q >> 1]);
                    v[q] = (g * v[q]) * (u * c2); }
                if constexpr (OUT_FP8) { v2u w; w.x = pk4_fp8(v[0].x, v[0].y, v[1].x, v[1].y); w.y = pk4_fp8(v[2].x, v[2].y, v[3].x, v[3].y);
                    *(GAS v2u*)(O + (size_t)(row0 + ai * HALF + m * 16) * ldc + c0) = w; }
                else { u32x4 w; w.x = cvt_pk_bf16(v[0].x, v[0].y); w.y = cvt_pk_bf16(v[1].x, v[1].y); w.z = cvt_pk_bf16(v[2].x, v[2].y); w.w = cvt_pk_bf16(v[3].x, v[3].y);
                    *(GAS u32x4*)((bf16*)O + (size_t)(row0 + ai * HALF + m * 16) * ldc + c0) = w; } }
    }
};
}

#define XB_TMO      128
#define XB_XCNT(j)  (256  + 64 * (j))
#define XB_XSUB(j)  (1280 + 64 * (j))
#define XB_XGEN(j)  (2304 + 64 * (j))
#define XB_TOP      3328
#define XB_TOPGEN   3392
#define XCD_BAR_WORDS 3456
#define XB_SPIN_CAP (1u << 18)
__device__ __forceinline__ unsigned xb_ld(unsigned* p)              { return __hip_atomic_load(p, __ATOMIC_RELAXED, __HIP_MEMORY_SCOPE_AGENT); }
__device__ __forceinline__ unsigned xb_add(unsigned* p, unsigned v) { return __hip_atomic_fetch_add(p, v, __ATOMIC_RELAXED, __HIP_MEMORY_SCOPE_AGENT); }
__device__ __forceinline__ unsigned xb_xcc_id() { return (unsigned)__builtin_amdgcn_s_getreg((3 << 11) | 20) & 0xFu; }
#define XB_SPIN(cond, bar) do { unsigned _sp = 0; while (cond) { __builtin_amdgcn_s_sleep(1); \
    if ((++_sp & 255u) == 0u) { if (xb_ld(&(bar)[XB_TMO])) break; if (_sp > XB_SPIN_CAP) { atomicAdd(&(bar)[XB_TMO], 1u); break; } } } } while (0)
struct XcdBarrier { unsigned* bar; unsigned x; volatile LAS unsigned* st; };
__device__ __forceinline__ XcdBarrier xcd_barrier_post(unsigned* bar, volatile LAS unsigned* st) {
    XcdBarrier b; b.bar = bar; b.x = xb_xcc_id(); b.st = st;
    if (threadIdx.x == 0) (void)xb_add(&bar[XB_XCNT(b.x)], 1u);
    return b;
}
__device__ __forceinline__ void xcd_barrier_complete(unsigned* bar, unsigned x, unsigned& nloc, unsigned& nx) {
    const unsigned G = gridDim.x * gridDim.y * gridDim.z;
    unsigned sum, cnt, mine, sp = 0u;
    for (;;) {
        sum = 0u; cnt = 0u; mine = 0u;
#pragma unroll
        for (unsigned j = 0; j < 16; ++j) { const unsigned c = xb_ld(&bar[XB_XCNT(j)]); sum += c; cnt += (c > 0u) ? 1u : 0u; mine = (j == x) ? c : mine; }
        if (sum == G) break;
        __builtin_amdgcn_s_sleep(1);
        if ((++sp & 255u) == 0u) { if (xb_ld(&bar[XB_TMO])) break; if (sp > XB_SPIN_CAP) { atomicAdd(&bar[XB_TMO], 1u); break; } }
    }
    nloc = mine > 0u ? mine : 1u; nx = cnt > 0u ? cnt : 1u;
}
__device__ __forceinline__ void xcd_barrier(const XcdBarrier& b, const bool leader  ) {
    asm volatile("s_waitcnt vmcnt(0)" ::: "memory");
    __syncthreads();
    if (leader) {
        unsigned* bar = b.bar; asm volatile("" : "+s"(bar));
        __builtin_amdgcn_s_waitcnt(0);
        unsigned bx = b.x; asm volatile("" : "+s"(bx));
        unsigned nloc = b.st[0], nx = b.st[1];
        if (nloc == 0u) { xcd_barrier_complete(bar, bx, nloc, nx); b.st[0] = nloc; b.st[1] = nx; }
        const unsigned old = xb_add(&bar[XB_XSUB(bx)], 1u);
        const unsigned gen = old / nloc;
        if (old + 1u == (gen + 1u) * nloc) {
            __builtin_amdgcn_fence(__ATOMIC_RELEASE, "agent");
            asm volatile("s_waitcnt vmcnt(0)" ::: "memory");
            const unsigned og = xb_add(&bar[XB_TOP], 1u);
            const unsigned tg = og / nx;
            if (og + 1u == (tg + 1u) * nx) xb_add(&bar[XB_TOPGEN], 1u);
            else XB_SPIN(xb_ld(&bar[XB_TOPGEN]) == tg, bar);
            __builtin_amdgcn_fence(__ATOMIC_ACQUIRE, "agent");
            xb_add(&bar[XB_XGEN(bx)], 1u);
            asm volatile("s_waitcnt vmcnt(0)" ::: "memory");
        } else {
            XB_SPIN(xb_ld(&bar[XB_XGEN(bx)]) == gen, bar);
            __builtin_amdgcn_fence(__ATOMIC_ACQUIRE, "agent");
            asm volatile("s_waitcnt vmcnt(0)" ::: "memory");
        }
    }
    __syncthreads();
}

struct Frame {
    LAS unsigned char* lds;
    int wave, vcu, G;
    unsigned char* ws; const float* const* in; float* out;
};
template <class T> __device__ __forceinline__ T* wsp(const Frame& F, size_t off) { return (T*)(F.ws + off); }

enum { I_X = 0, I_MEM, I_MIXG, I_WIN, I_SBQG, I_SBKG, I_GAUP, I_GAB, I_GOG, I_CAQG, I_CAKG, I_MEMG, I_WMKV, I_WBRSB, I_WBRGLA, I_WBRCA, I_WOUT, I_FFNG,
       I_FFGU, I_FFDN, I_ROUTER, I_MOEGU, I_MOEDN, N_IN };

__device__ __forceinline__ void tr_store(bf16* dst, int dp, LAS float* scr, int lane) {
    LDS_WAIT(); asm volatile("" ::: "memory");
    const int c = lane & 7;
#pragma unroll
    for (int j = 0; j < 4; ++j) { const int n = (lane >> 3) + 8 * j; const LAS float* s = scr + (8 * c) * 33 + n;
        v4u o; o.x = pk2(s[0 * 33], s[1 * 33]); o.y = pk2(s[2 * 33], s[3 * 33]); o.z = pk2(s[4 * 33], s[5 * 33]); o.w = pk2(s[6 * 33], s[7 * 33]);
        *(GAS v4u*)(dst + (size_t)n * dp + 8 * c) = o; }
    LDS_WAIT(); asm volatile("" ::: "memory");
}
__device__ __forceinline__ void tr_item(const float* src, int sp, bf16* dst, int dp, LAS float* scr, int lane) {
#pragma unroll 8
    for (int i = 0; i < 32; ++i) { const int kk = 2 * i + (lane >> 5); scr[kk * 33 + (lane & 31)] = src[(size_t)kk * sp + (lane & 31)]; }
    tr_store(dst, dp, scr, lane);
}
__device__ __forceinline__ void tr_item_fp8(const float* src, int sp, unsigned char* dst, int dp, float scale, LAS float* scr, int lane) {
#pragma unroll 8
    for (int i = 0; i < 32; ++i) { const int kk = 2 * i + (lane >> 5); scr[kk * 33 + (lane & 31)] = src[(size_t)kk * sp + (lane & 31)] * scale; }
    LDS_WAIT(); asm volatile("" ::: "memory");
    const int c = lane & 7;
#pragma unroll
    for (int j = 0; j < 4; ++j) { const int n = (lane >> 3) + 8 * j; const LAS float* s = scr + (8 * c) * 33 + n;
        v2u o; o.x = pk4_fp8(s[0 * 33], s[1 * 33], s[2 * 33], s[3 * 33]); o.y = pk4_fp8(s[4 * 33], s[5 * 33], s[6 * 33], s[7 * 33]);
        *(GAS v2u*)(dst + (size_t)n * dp + 8 * c) = o; }
    LDS_WAIT(); asm volatile("" ::: "memory");
}
template <bool FP8> __device__ __forceinline__ void tr_item_ga(const float* win_k0  , const float* up_n0  , bf16* dst, int dp, LAS float* scr, int lane) {
    float u[16];
#pragma unroll
    for (int r = 0; r < 16; ++r) u[r] = up_n0[r * 256 + (lane & 31)];
#pragma unroll 4
    for (int i = 0; i < 32; ++i) { const int kk = 2 * i + (lane >> 5); const float* w = win_k0 + (size_t)kk * IN_W; float s = 0.f;
#pragma unroll
        for (int r = 0; r < 16; ++r) s += w[r] * u[r];
        scr[kk * 33 + (lane & 31)] = FP8 ? s * 32.f : s; }
    if constexpr (FP8) {
        LDS_WAIT(); asm volatile("" ::: "memory");
        const int c = lane & 7; unsigned char* d8 = (unsigned char*)dst;
#pragma unroll
        for (int j = 0; j < 4; ++j) { const int n = (lane >> 3) + 8 * j; const LAS float* s_ = scr + (8 * c) * 33 + n;
            v2u o; o.x = pk4_fp8(s_[0 * 33], s_[1 * 33], s_[2 * 33], s_[3 * 33]); o.y = pk4_fp8(s_[4 * 33], s_[5 * 33], s_[6 * 33], s_[7 * 33]);
            *(GAS v2u*)(d8 + (size_t)n * dp + 8 * c) = o; }
        LDS_WAIT(); asm volatile("" ::: "memory");
    } else tr_store(dst, dp, scr, lane);
}

__device__ __forceinline__ void rms_row_to_bf16(const float* xrow, const float* gain, bf16* orow, int lane) {
    const f32x4* xr = (const f32x4*)xrow + lane; const f32x4* gr = (const f32x4*)gain + lane;
    f32x4 v[4]; float s = 0.f;
#pragma unroll
    for (int j = 0; j < 4; ++j) { v[j] = xr[64 * j]; s += (v[j].x * v[j].x + v[j].y * v[j].y) + (v[j].z * v[j].z + v[j].w * v[j].w); }
    const float rstd = 1.f / sqrtf(wave_sum(s, lane >> 5) * (1.f / 1024.f) + EPS);
    unsigned long long* o8 = (unsigned long long*)orow + lane;
#pragma unroll
    for (int j = 0; j < 4; ++j) { const f32x4 g = gr[64 * j];
        o8[64 * j] = (unsigned long long)pk2(v[j].x * rstd * g.x, v[j].y * rstd * g.y) | ((unsigned long long)pk2(v[j].z * rstd * g.z, v[j].w * rstd * g.w) << 32); }
}

template <int OUT, bool XBF = false> __device__ __forceinline__ void rms_rows(const void* x, int nrows, const float* gain, unsigned char* obase, int gw, int NGW, int lane, unsigned char* obase8 = nullptr);
struct TrItem { const float* src; const float* up; unsigned char* dst; int sp, dp, mode; float scale; };
__device__ __forceinline__ TrItem tr_decode(const Frame& F, int it) {
    constexpr int KB = 1024 / 64;
    constexpr int I_IN = KB * (IN_WP / 32), I_MKV = KB * 32, I_BR = (512 / 64) * 32, I_OUT = KB * 32;
    constexpr int I_GU0 = KB * (2 * DFF / 32), I_DN0 = (DFF / 64) * 32, I_GUE = KB * (2 * DFFE / 32), I_DNE = (DFFE / 64) * 32;
    constexpr int PER_LAYER = I_IN + I_MKV + 3 * I_BR + I_OUT;
    TrItem t; t.up = nullptr; t.mode = 0; t.scale = 1.f; int r = it;
    if (r < 2 * PER_LAYER) {
        const int l = r / PER_LAYER; r -= l * PER_LAYER;
        if (r < I_IN) { const int nb = r % (IN_WP / 32), kb = r / (IN_WP / 32); const int n0 = nb * 32, k0 = kb * 64;
            const float* W = F.in[I_WIN] + (size_t)l * 1024 * IN_W; unsigned char* WT = F.ws + WS_WIN + (size_t)l * IN_WP * 1024 * 2;
            t.sp = IN_W; t.dp = 2048; t.dst = WT + (size_t)n0 * 2048 + k0 * 2;
            if (n0 >= 3840) { t.mode = 1; t.scale = 32.f; t.dp = 1024; t.dst = WT + (size_t)3840 * 2048 + (size_t)(n0 - 3840) * 1024 + k0; }
            if (n0 >= 2560 && n0 < 2816) { t.mode = 2; t.src = W + (size_t)k0 * IN_W + 2560; t.up = F.in[I_GAUP] + (size_t)l * 16 * 256 + (n0 - 2560); }
            else t.src = W + (size_t)k0 * IN_W + ((n0 < 2560) ? n0 : n0 - 240);
            return t; }
        r -= I_IN;
        if (r < I_MKV) { const int nb = r % 32, kb = r / 32; t.src = F.in[I_WMKV] + (size_t)l * 1024 * 1024 + (size_t)kb * 64 * 1024 + nb * 32; t.sp = 1024;
            t.dst = F.ws + WS_WMKV + ((size_t)l * 1024 * 1024 + (size_t)nb * 32 * 1024 + kb * 64) * 2; t.dp = 2048; return t; }
        r -= I_MKV;
        if (r < 3 * I_BR) { const int br = r / I_BR; r -= br * I_BR; const int nb = r % 32, kb = r / 32;
            t.src = F.in[I_WBRSB + br] + (size_t)l * 512 * 1024 + (size_t)kb * 64 * 1024 + nb * 32; t.sp = 1024;
            t.dst = F.ws + WS_WBR + ((size_t)l * 1024 * 1536 + (size_t)nb * 32 * 1536 + br * 512 + kb * 64) * 2; t.dp = 3072; return t; }
        r -= 3 * I_BR;
        { const int nb = r % 32, kb = r / 32; t.src = F.in[I_WOUT] + (size_t)l * 1024 * 1024 + (size_t)kb * 64 * 1024 + nb * 32; t.sp = 1024;
            t.dst = F.ws + WS_WOUT + ((size_t)l * 1024 * 1024 + (size_t)nb * 32 * 1024 + kb * 64) * 2; t.dp = 2048; return t; }
    }
    r -= 2 * PER_LAYER;
    if (r < I_GU0) {
        const int nb = r % (2 * DFF / 32), kb = r / (2 * DFF / 32); const int sc = nb * 32; const bool up = sc >= DFF; const int ch = up ? sc - DFF : sc;
        const int drow = 256 * (ch / 128) + (up ? 128 : 0) + (ch % 128);
        t.src = F.in[I_FFGU] + (size_t)kb * 64 * (2 * DFF) + sc; t.sp = 2 * DFF; t.dst = F.ws + WS_WGU0 + ((size_t)drow * 1024 + kb * 64) * 2; t.dp = 2048; return t; }
    r -= I_GU0;
    if (r < I_DN0) { const int nb = r % 32, kb = r / 32; t.src = F.in[I_FFDN] + (size_t)kb * 64 * 1024 + nb * 32; t.sp = 1024;
        t.dst = F.ws + WS_WDN0 + (size_t)nb * 32 * DFF + kb * 64; t.dp = DFF; t.mode = 1; t.scale = 64.f; return t; }
    r -= I_DN0;
    if (r < NEXP * I_GUE) { const int e = r / I_GUE; r -= e * I_GUE;
        const int nb = r % (2 * DFFE / 32), kb = r / (2 * DFFE / 32); const int sc = nb * 32; const bool up = sc >= DFFE; const int ch = up ? sc - DFFE : sc;
        const int drow = 256 * (ch / 128) + (up ? 128 : 0) + (ch % 128);
        t.src = F.in[I_MOEGU] + (size_t)e * 1024 * (2 * DFFE) + (size_t)kb * 64 * (2 * DFFE) + sc; t.sp = 2 * DFFE;
        t.dst = F.ws + WS_WGUE + (size_t)e * (2 * DFFE) * 1024 + (size_t)drow * 1024 + kb * 64; t.dp = 1024; t.mode = 1; t.scale = 32.f; return t; }
    r -= NEXP * I_GUE;
    { const int e = r / I_DNE; r -= e * I_DNE; const int nb = r % 32, kb = r / 32;
        t.src = F.in[I_MOEDN] + (size_t)e * DFFE * 1024 + (size_t)kb * 64 * 1024 + nb * 32; t.sp = 1024;
        t.dst = F.ws + WS_WDNE + (size_t)e * 1024 * DFFE + (size_t)nb * 32 * DFFE + kb * 64; t.dp = DFFE; t.mode = 1; t.scale = 64.f; return t; }
}
__device__ __forceinline__ void tr_load(const TrItem& t, int lane, float (&v)[32]) {
    if (t.mode == 2) {
        float u[16];
#pragma unroll
        for (int r = 0; r < 16; ++r) u[r] = t.up[r * 256 + (lane & 31)];
#pragma unroll 4
        for (int i = 0; i < 32; ++i) { const float* w = t.src + (size_t)(2 * i + (lane >> 5)) * IN_W; float s_ = 0.f;
#pragma unroll
            for (int r = 0; r < 16; ++r) s_ += w[r] * u[r];
            v[i] = s_; }
    } else {
        const float* p_ = t.src + (size_t)(lane >> 5) * t.sp + (lane & 31); const size_t st = (size_t)2 * t.sp;
#pragma unroll
        for (int i = 0; i < 32; ++i) v[i] = __builtin_nontemporal_load(p_ + i * st);
    }
}
__device__ __forceinline__ void tr_emit(const TrItem& t, int lane, const float (&v)[32], LAS float* scr) {
#pragma unroll
    for (int i = 0; i < 32; ++i) scr[(2 * i + (lane >> 5)) * 33 + (lane & 31)] = v[i] * t.scale;
    LDS_WAIT(); asm volatile("" ::: "memory");
    const int c = lane & 7;
#pragma unroll
    for (int j = 0; j < 4; ++j) { const int n = (lane >> 3) + 8 * j; const LAS float* s_ = scr + (8 * c) * 33 + n;
        if (t.mode == 1) { v2u o; o.x = pk4_fp8(s_[0 * 33], s_[1 * 33], s_[2 * 33], s_[3 * 33]); o.y = pk4_fp8(s_[4 * 33], s_[5 * 33], s_[6 * 33], s_[7 * 33]);
            *(GAS v2u*)(t.dst + (size_t)n * t.dp + 8 * c) = o; }
        else { v4u o; o.x = pk2(s_[0 * 33], s_[1 * 33]); o.y = pk2(s_[2 * 33], s_[3 * 33]); o.z = pk2(s_[4 * 33], s_[5 * 33]); o.w = pk2(s_[6 * 33], s_[7 * 33]);
            *(GAS v4u*)(t.dst + (size_t)n * t.dp + 16 * c) = o; } }
    LDS_WAIT(); asm volatile("" ::: "memory");
}
__device__ __forceinline__ void phase_prologue(const Frame& F) {
    LAS float* scr = (LAS float*)(F.lds + F.wave * 16384);
    const int gw = F.vcu * 8 + F.wave, NGW = F.G * 8, lane = lane_fresh();
    constexpr int KB = 1024 / 64;
    constexpr int NITEMS = 2 * (KB * (IN_WP / 32) + KB * 32 + 3 * (512 / 64) * 32 + KB * 32) + KB * (2 * DFF / 32) + (DFF / 64) * 32 + NEXP * (KB * (2 * DFFE / 32) + (DFFE / 64) * 32);
    float va[32], vb[32];
    unsigned* tick = (unsigned*)(F.ws + WS_CTL) + CW_PTICK + (gw & 63) * 64; const int shard = gw & 63;
#define PRO_DRAW() ({ unsigned t_ = 0u; if (lane == 0) t_ = __hip_atomic_fetch_add(tick, 1u, __ATOMIC_RELAXED, __HIP_MEMORY_SCOPE_AGENT); t_; })
    unsigned d1 = PRO_DRAW(), d2 = PRO_DRAW();
    int it = shard + 64 * (int)__builtin_amdgcn_readfirstlane(d1); TrItem ta, tb;
    if (it < NITEMS) { ta = tr_decode(F, it); tr_load(ta, lane, va); }
    while (it < NITEMS) {
        const int itn = shard + 64 * (int)__builtin_amdgcn_readfirstlane(d2); d2 = PRO_DRAW(); const bool more = itn < NITEMS;
        if (more) { tb = tr_decode(F, itn); tr_load(tb, lane, vb); }
        tr_emit(ta, lane, va, scr);
        if (more) { ta = tb;
#pragma unroll
            for (int i = 0; i < 32; ++i) va[i] = vb[i]; }
        it = itn;
    }
#undef PRO_DRAW
    rms_rows<2>(F.in[I_X], MTOK, F.in[I_MIXG], wsp<unsigned char>(F, WS_HBUF), gw, NGW, lane, wsp<unsigned char>(F, WS_HB8));
    rms_rows<0>(F.in[I_MEM], MMEM, F.in[I_MEMG], wsp<unsigned char>(F, WS_HMEM), gw, NGW, lane);
    rms_rows<0>(F.in[I_MEM], MMEM, F.in[I_MEMG] + 1024, wsp<unsigned char>(F, WS_HMEM) + (size_t)MMEM * 2048, gw, NGW, lane);
}

__device__ __forceinline__ void rms_row_to_fp8(const float* xrow, const float* gain, unsigned char* orow, int lane) {
    const f32x4* xr = (const f32x4*)xrow + lane; const f32x4* gr = (const f32x4*)gain + lane;
    f32x4 v[4]; float s = 0.f;
#pragma unroll
    for (int j = 0; j < 4; ++j) { v[j] = xr[64 * j]; s += (v[j].x * v[j].x + v[j].y * v[j].y) + (v[j].z * v[j].z + v[j].w * v[j].w); }
    const float rstd = 1.f / sqrtf(wave_sum(s, lane >> 5) * (1.f / 1024.f) + EPS);
    unsigned* o4 = (unsigned*)orow + lane;
#pragma unroll
    for (int j = 0; j < 4; ++j) { const f32x4 g = gr[64 * j]; o4[64 * j] = pk4_fp8(v[j].x * rstd * g.x, v[j].y * rstd * g.y, v[j].z * rstd * g.z, v[j].w * rstd * g.w); }
}
__device__ __forceinline__ void phase_rms_fp8(const Frame& F, const bf16* x, const float* gain) {
    const int gw = F.vcu * 8 + F.wave, NGW = F.G * 8, lane = lane_fresh();
    rms_rows<1, true>(x, MTOK, gain, wsp<unsigned char>(F, WS_HBUF), gw, NGW, lane);
}
template <int OUT, bool XBF> __device__ __forceinline__ void rms_rows(const void* x, int nrows, const float* gain, unsigned char* obase, int gw, int NGW, int lane, unsigned char* obase8) {
    f32x4 g[4];
#pragma unroll
    for (int j = 0; j < 4; ++j) g[j] = *((const GAS f32x4*)gain + lane + 64 * j);
    for (int m0 = gw; m0 < nrows; m0 += 4 * NGW) {
        f32x4 v[4][4];
#pragma unroll
        for (int k = 0; k < 4; ++k) { const int m = m0 + k * NGW; if (m < nrows) {
#pragma unroll
            for (int j = 0; j < 4; ++j) v[k][j] = ldx4<XBF>((const unsigned char*)x + (size_t)m * (XBF ? XBP * 2 : 4096), lane + 64 * j); } }
#pragma unroll
        for (int k = 0; k < 4; ++k) { const int m = m0 + k * NGW; if (m < nrows) {
            float s_ = 0.f;
#pragma unroll
            for (int j = 0; j < 4; ++j) s_ += (v[k][j].x * v[k][j].x + v[k][j].y * v[k][j].y) + (v[k][j].z * v[k][j].z + v[k][j].w * v[k][j].w);
            const float rstd = 1.f / sqrtf(wave_sum(s_, lane >> 5) * (1.f / 1024.f) + EPS);
#pragma unroll
            for (int j = 0; j < 4; ++j) { const f32x4 y = v[k][j] * rstd * g[j];
                if (OUT == 1) *((GAS unsigned*)(obase + (size_t)m * 1024) + lane + 64 * j) = pk4_fp8(y.x, y.y, y.z, y.w);
                else *((GAS v2u*)(obase + (size_t)m * 2048) + lane + 64 * j) = (v2u){pk2(y.x, y.y), pk2(y.z, y.w)};
                if (OUT == 2) *((GAS unsigned*)(obase8 + (size_t)m * 1024) + lane + 64 * j) = pk4_fp8(y.x, y.y, y.z, y.w); } } }
    }
}
__device__ __forceinline__ void phase_rms(const Frame& F, const bf16* x, const float* gain, bool dual = false) {
    const int gw = F.vcu * 8 + F.wave, NGW = F.G * 8, lane = lane_fresh();
    if (dual) rms_rows<2, true>(x, MTOK, gain, wsp<unsigned char>(F, WS_HBUF), gw, NGW, lane, wsp<unsigned char>(F, WS_HB8));
    else rms_rows<0, true>(x, MTOK, gain, wsp<unsigned char>(F, WS_HBUF), gw, NGW, lane);
}

template <int HD> __device__ __forceinline__ void headnorm_rows(const Frame& F, bf16* buf, int rows, const float* gain, float scale) {
    const int gw = F.vcu * 8 + F.wave, NGW = F.G * 8, lane = lane_fresh();
    const int d0 = (lane * 8) & (HD - 1);
    float g[8];
#pragma unroll
    for (int j = 0; j < 8; ++j) g[j] = gain[d0 + j] * scale;
    for (int m = gw; m < rows; m += NGW) {
        v4u* p = (v4u*)(buf + (size_t)m * 512) + lane; const v4u w = *p; float x[8];
        x[0] = bflo(w.x); x[1] = bfhi(w.x); x[2] = bflo(w.y); x[3] = bfhi(w.y); x[4] = bflo(w.z); x[5] = bfhi(w.z); x[6] = bflo(w.w); x[7] = bfhi(w.w);
        float s = 0.f;
#pragma unroll
        for (int j = 0; j < 8; ++j) s += x[j] * x[j];
        s += swz_xor<1>(s); s += swz_xor<2>(s); s += swz_xor<4>(s); if (HD == 128) s += swz_xor<8>(s);
        const float rstd = 1.f / sqrtf(s * (1.f / HD) + EPS);
        v4u o; o.x = pk2(x[0] * rstd * g[0], x[1] * rstd * g[1]); o.y = pk2(x[2] * rstd * g[2], x[3] * rstd * g[3]); o.z = pk2(x[4] * rstd * g[4], x[5] * rstd * g[5]); o.w = pk2(x[6] * rstd * g[6], x[7] * rstd * g[7]);
        *p = o;
    }
}

__device__ __forceinline__ s16x4 vtr(const LAS unsigned char* p) { typedef short v4i16_t __attribute__((ext_vector_type(4))); return __builtin_bit_cast(s16x4, __builtin_amdgcn_ds_read_tr16_b64_v4i16((LAS v4i16_t*)p)); }
#define MK8(lo, hi) (bf16x8){lo[0], lo[1], lo[2], lo[3], hi[0], hi[1], hi[2], hi[3]}

__device__ __forceinline__ v4u scale8(v4u w, float rstd, const float (&g)[8]) {
    v4u o; o.x = cvt_pk_bf16(bflo(w.x) * rstd * g[0], bfhi(w.x) * rstd * g[1]); o.y = cvt_pk_bf16(bflo(w.y) * rstd * g[2], bfhi(w.y) * rstd * g[3]);
    o.z = cvt_pk_bf16(bflo(w.z) * rstd * g[4], bfhi(w.z) * rstd * g[5]); o.w = cvt_pk_bf16(bflo(w.w) * rstd * g[6], bfhi(w.w) * rstd * g[7]); return o; }
__device__ __forceinline__ float sumsq8(v4u w) { const float a = bflo(w.x), b = bfhi(w.x), c = bflo(w.y), d = bfhi(w.y), e = bflo(w.z), f = bfhi(w.z), g = bflo(w.w), h = bfhi(w.w);
    return ((a * a + b * b) + (c * c + d * d)) + ((e * e + f * f) + (g * g + h * h)); }


template <bool MASK, bool DO_PV> __device__ __forceinline__ void sb2_body(const LAS unsigned char* kbn  , const LAS unsigned char* vbp  ,
        const bf16x8 (&qr)[4], f32x16& pc0, f32x16& pc1, unsigned (&pw)[16], f32x16 (&o)[2], float& carry, int kq, int hi) {
    f32x16 pn0 = f32x16{}, pn1 = f32x16{};
    float A[8], u0[16], u1[16];
#pragma unroll
    for (int sl = 0; sl < 4; ++sl) {
        const bf16x8 k0 = *(const LAS bf16x8*)(kbn + sl * 2048), k1 = *(const LAS bf16x8*)(kbn + sl * 2048 + 512);
#pragma unroll
        for (int j = 0; j < 4; ++j) { const int r = 4 * sl + j;
            float ua = ex2(__builtin_amdgcn_fmed3f(pc0[r], -200.f, 30.f)), ub = ex2(__builtin_amdgcn_fmed3f(pc1[r], -200.f, 30.f));
            if (MASK) { const int kr = kq + (r & 3) + 8 * (r >> 2); ua = (kr < 0) ? ua : 0.f; ub = (kr + 32 < 0) ? ub : 0.f; }
            u0[r] = ua; u1[r] = ub; }
        A[sl] = ((1.f + u0[4 * sl]) * (1.f + u0[4 * sl + 1])) * ((1.f + u0[4 * sl + 2]) * (1.f + u0[4 * sl + 3]));
        A[4 + sl] = ((1.f + u1[4 * sl]) * (1.f + u1[4 * sl + 1])) * ((1.f + u1[4 * sl + 2]) * (1.f + u1[4 * sl + 3]));
        pn0 = __builtin_amdgcn_mfma_f32_32x32x16_bf16(k0, qr[sl], pn0, 0, 0, 0); pn1 = __builtin_amdgcn_mfma_f32_32x32x16_bf16(k1, qr[sl], pn1, 0, 0, 0);
        __builtin_amdgcn_sched_group_barrier(0x100, 2, 0); __builtin_amdgcn_sched_group_barrier(0x2, 64, 0); __builtin_amdgcn_sched_group_barrier(0x8, 2, 0);
        __builtin_amdgcn_sched_barrier(0);
    }
    float Bo[8], R[8];
#pragma unroll
    for (int g = 0; g < 8; ++g) Bo[g] = other_half(A[g], hi);
    R[7] = carry;
#pragma unroll
    for (int g = 6; g >= 0; --g) R[g] = R[g + 1] * (A[g + 1] * Bo[g + 1]);
    carry = R[0] * (A[0] * Bo[0]);
#pragma unroll
    for (int kg = 0; kg < 4; ++kg) {
        s16x4 lo0, hh0, lo1, hh1;
        if (DO_PV) { lo0 = vtr(vbp + kg * 1024); hh0 = vtr(vbp + kg * 1024 + 512); lo1 = vtr(vbp + 4096 + kg * 1024); hh1 = vtr(vbp + 4096 + kg * 1024 + 512); }
        unsigned nw[4];
#pragma unroll
        for (int gi = 0; gi < 2; ++gi) { const int g = 2 * kg + gi;
            const float ua = (g < 4) ? u0[4 * g] : u1[4 * (g - 4)], ub = (g < 4) ? u0[4 * g + 1] : u1[4 * (g - 4) + 1], uc = (g < 4) ? u0[4 * g + 2] : u1[4 * (g - 4) + 2], ud = (g < 4) ? u0[4 * g + 3] : u1[4 * (g - 4) + 3];
            const float e0 = rcpf_((R[g] * (hi ? 1.f : Bo[g])) * A[g]);
            const float e1 = __builtin_fmaf(e0, ua, e0), e2 = __builtin_fmaf(e1, ub, e1), e3 = __builtin_fmaf(e2, uc, e2);
            nw[2 * gi] = cvt_pk_bf16(ua * e0, ub * e1); nw[2 * gi + 1] = cvt_pk_bf16(uc * e2, ud * e3); }
        if (DO_PV) { const bf16x8 pa = __builtin_bit_cast(bf16x8, (v4u){pw[4 * kg], pw[4 * kg + 1], pw[4 * kg + 2], pw[4 * kg + 3]});
            o[0] = __builtin_amdgcn_mfma_f32_32x32x16_bf16(pa, MK8(lo0, hh0), o[0], 0, 0, 0); o[1] = __builtin_amdgcn_mfma_f32_32x32x16_bf16(pa, MK8(lo1, hh1), o[1], 0, 0, 0);
            __builtin_amdgcn_sched_group_barrier(0x100, 4, 0); __builtin_amdgcn_sched_group_barrier(0x2, 64, 0); __builtin_amdgcn_sched_group_barrier(0x8, 2, 0); }
        __builtin_amdgcn_sched_barrier(0);
#pragma unroll
        for (int j = 0; j < 4; ++j) pw[4 * kg + j] = nw[j];
    }
    pc0 = pn0; pc1 = pn1;
}

__device__ __forceinline__ void sb_attn_unit(LAS unsigned char* lds, int b, int h, int qb, const bf16* Q, const bf16* K, const bf16* V, bf16* O  , const float* gq, const float* gk, const int wid) {
    const int lane = lane_fresh(), tid = wid * 64 + lane, r32 = lane & 31, hi = lane >> 5;
    const size_t rowbase = (size_t)b * SEQ; const int q0 = qb * 256;
    const int rb = (wid < 4) ? wid : 11 - wid;
    const bf16* Qw = Q + (rowbase + q0 + rb * 32) * 512 + h * 64;
    const bf16* Kh = K + rowbase * 512 + h * 64; const bf16* Vh = V + rowbase * 512 + h * 64;
    const int kkey = tid >> 3, kch = tid & 7;
#define SB_KSRC (Kh + (size_t)((wid * 64 + lane_fresh()) >> 3) * 512 + (lane_fresh() & 7) * 8)
#define SB_VSRC (Vh + (size_t)(16 * (wid & 3) + (lane_fresh() >> 2)) * 512 + (wid >> 2) * 32 + (lane_fresh() & 3) * 8)
#define SB_KSTOFF ((lane_fresh() & 7) * 1024 + ((wid * 64 + lane_fresh()) >> 3) * 16)
#define SB_STOFF (wid * 1024 + lane_fresh() * 16)
    float gkr[8];
#pragma unroll
    for (int j = 0; j < 8; ++j) gkr[j] = gk[kch * 8 + j];
    bf16x8 qr[4];
    { v4u qw[4]; float ss = 0.f;
#pragma unroll
      for (int d0 = 0; d0 < 4; ++d0) { qw[d0] = *(const GAS v4u*)(Qw + (size_t)r32 * 512 + d0 * 16 + hi * 8); ss += sumsq8(qw[d0]); }
      ss += other_half(ss, hi);
      const float rstd = (0.125f * LOG2E) / sqrtf(ss * (1.f / 64.f) + EPS);
#pragma unroll
      for (int d0 = 0; d0 < 4; ++d0) { float g[8];
#pragma unroll
          for (int j = 0; j < 8; ++j) g[j] = gq[d0 * 16 + hi * 8 + j];
          qr[d0] = __builtin_bit_cast(bf16x8, scale8(qw[d0], rstd, g)); } }
    const int NT = (q0 + 256) / 64, NG = NT / 2;
    f32x16 o[2]; o[0] = f32x16{}; o[1] = f32x16{};
    float carry = 1.f;
    const int kfo = hi * 1024 + r32 * 16;
    const int vfo = ((lane >> 4) & 1) * 32 + (lane & 3) * 8 + (4 * hi + ((lane & 15) >> 2)) * 64;
    constexpr int VB = 49152;
    constexpr int SB_FLAG = 98304;
    constexpr float SB_DONE_D = 1099511627776.f;
#define SB_LOADK(gg, dst) do { _Pragma("unroll") for (int i_ = 0; i_ < 2; ++i_) dst[i_] = *(const GAS v4u*)(SB_KSRC + (size_t)(NT - 1 - 2 * (gg) - i_) * 64 * 512); } while (0)
#define SB_LOADV(gg, dst) do { _Pragma("unroll") for (int i_ = 0; i_ < 2; ++i_) dst[i_] = *(const GAS v4u*)(SB_VSRC + (size_t)(NT - 1 - 2 * (gg) - i_) * 64 * 512); } while (0)
#define SB_STOREK(gg, src) do { _Pragma("unroll") for (int i_ = 0; i_ < 2; ++i_) { float ss_ = sumsq8(src[i_]); ss_ += swz_xor<1>(ss_); ss_ += swz_xor<2>(ss_); ss_ += swz_xor<4>(ss_); \
        *(LAS v4u*)(lds + ((gg) % 3) * 16384 + i_ * 8192 + SB_KSTOFF) = scale8(src[i_], __builtin_amdgcn_rsqf(ss_ * (1.f / 64.f) + EPS), gkr); } } while (0)
#define SB_STOREV(gg, src) do { _Pragma("unroll") for (int i_ = 0; i_ < 2; ++i_) *(LAS v4u*)(lds + VB + ((gg) % 3) * 16384 + i_ * 8192 + SB_STOFF) = src[i_]; } while (0)
#define SB_KB(i) (lds + (((i) >> 1) % 3) * 16384 + ((i) & 1) * 8192 + kfo)
#define SB_VBASE(i) (lds + VB + (((i) >> 1) % 3) * 16384 + ((i) & 1) * 8192 + vfo)
    v4u kreg[2], vreg[2];
    if (tid < 4) *(volatile LAS unsigned*)(lds + SB_FLAG + 4 * tid) = 0u;
    SB_LOADK(0, kreg); SB_LOADV(0, vreg); SB_STOREK(0, kreg); SB_STOREV(0, vreg);
    if (NG > 1) { SB_LOADK(1, kreg); SB_STOREK(1, kreg); SB_LOADV(1, vreg); }
    if (NG > 2) SB_LOADK(2, kreg);
    __syncthreads();
    f32x16 pc0 = f32x16{}, pc1 = f32x16{}; unsigned pw[16];
#pragma unroll
    for (int i = 0; i < 16; ++i) pw[i] = 0u;
    const int i0 = 3 - (rb >> 1);
    { const LAS unsigned char* kb = SB_KB(i0);
#pragma unroll
      for (int d0 = 0; d0 < 4; ++d0) { const bf16x8 k0 = *(const LAS bf16x8*)(kb + d0 * 2048), k1 = *(const LAS bf16x8*)(kb + d0 * 2048 + 512);
          pc0 = __builtin_amdgcn_mfma_f32_32x32x16_bf16(k0, qr[d0], pc0, 0, 0, 0); pc1 = __builtin_amdgcn_mfma_f32_32x32x16_bf16(k1, qr[d0], pc1, 0, 0, 0); } }
    const int kq0 = 4 * hi - (rb * 32 + r32);
#define SB_STAGE(g) do { __builtin_amdgcn_sched_barrier(0); if ((g) + 1 < NG) SB_STOREK((g) + 1, kreg); SB_STOREV((g), vreg); if ((g) + 2 < NG) SB_LOADK((g) + 2, kreg); if ((g) + 1 < NG) SB_LOADV((g) + 1, vreg); __syncthreads(); __builtin_amdgcn_sched_barrier(0); } while (0)
#define SB_DRAIN(i) do { const LAS unsigned char* vbp_ = SB_VBASE(i); _Pragma("unroll") for (int kg = 0; kg < 4; ++kg) { \
        const bf16x8 pa = __builtin_bit_cast(bf16x8, (v4u){pw[4 * kg], pw[4 * kg + 1], pw[4 * kg + 2], pw[4 * kg + 3]}); \
        _Pragma("unroll") for (int d0 = 0; d0 < 2; ++d0) { const s16x4 lo = vtr(vbp_ + d0 * 4096 + kg * 1024), hh = vtr(vbp_ + d0 * 4096 + kg * 1024 + 512); \
            o[d0] = __builtin_amdgcn_mfma_f32_32x32x16_bf16(pa, MK8(lo, hh), o[d0], 0, 0, 0); } } } while (0)
    bool wdone = false; int i = 0;
#pragma unroll 1
    for (; i < 4 && !wdone; ++i) {
        if (i == 2) SB_STAGE(1);
        if (i >= i0) {
            sb2_body<true, true>(SB_KB(i + 1), SB_VBASE(i > i0 ? i - 1 : i), qr, pc0, pc1, pw, o, carry, 64 * (3 - i) + kq0, hi);
            wdone = __builtin_amdgcn_ballot_w64(!(carry >= SB_DONE_D)) == 0ull; }
    }
    if (!wdone) {
#pragma unroll 1
        for (; i < NT; ++i) {
            if (!(i & 1)) { const int g_ = i >> 1;
                if (tid == 0) *(volatile LAS unsigned*)(lds + SB_FLAG + 4 * ((g_ + 1) & 3)) = 0u;
                if (lane == 0) *(volatile LAS unsigned*)(lds + SB_FLAG + 4 * (g_ & 3)) = 1u;
                SB_STAGE(g_); }
            sb2_body<false, true>(SB_KB(i + 1), SB_VBASE(i - 1), qr, pc0, pc1, pw, o, carry, 0, hi);
            if (__builtin_amdgcn_ballot_w64(!(carry >= SB_DONE_D)) == 0ull) { ++i; break; }
        }
    }
    SB_DRAIN(i - 1);
#pragma unroll 1
    for (; i < NT; ++i) {
        if (i == 2) SB_STAGE(1);
        else if (i >= 4 && !(i & 1)) { const int g_ = i >> 1;
            if (tid == 0) *(volatile LAS unsigned*)(lds + SB_FLAG + 4 * ((g_ + 1) & 3)) = 0u;
            SB_STAGE(g_);
            if (*(volatile LAS unsigned*)(lds + SB_FLAG + 4 * (g_ & 3)) == 0u) break; }
    }
#undef SB_STAGE
#undef SB_DRAIN
#undef SB_LOADK
#undef SB_KSRC
#undef SB_VSRC
#undef SB_KSTOFF
#undef SB_STOFF
#undef SB_LOADV
#undef SB_STOREK
#undef SB_STOREV
#undef SB_KB
#undef SB_VBASE
    __syncthreads();
    { LAS bf16* stg = (LAS bf16*)(lds + wid * 4096);
#pragma unroll
      for (int r = 0; r < 16; ++r) { const int orow = crow(r, hi);
#pragma unroll
          for (int d0 = 0; d0 < 2; ++d0) stg[orow * 64 + d0 * 32 + r32] = (bf16)f2bf(o[d0][r]); }
      LDS_WAIT();
      bf16* Ow = O + (rowbase + q0 + rb * 32) * 1536 + h * 64;
#pragma unroll
      for (int i = 0; i < 4; ++i) { const int row = i * 8 + (lane >> 3), ch = lane & 7; const v4u v = *(const LAS v4u*)(stg + row * 64 + ch * 8); *(GAS v4u*)(Ow + (size_t)row * 1536 + ch * 8) = v; } }
    __syncthreads();
}

__device__ __forceinline__ void ca_unit(LAS unsigned char* lds, int b, int h, int qb, const bf16* Q, const bf16* MKp, const bf16* MVp, bf16* O  , const float* gq, const float* gk, const int wid) {
    const int lane = lane_fresh(), tid = wid * 64 + lane, r32 = lane & 31, hi = lane >> 5;
    const bf16* Kh = MKp + (size_t)b * 256 * 512 + h * 128; const bf16* Vh = MVp + (size_t)b * 256 * 512 + h * 128;
    { float gkr[8];
#pragma unroll
      for (int j = 0; j < 8; ++j) gkr[j] = gk[(tid & 15) * 8 + j];
      v4u kin[8], vin[8];
#pragma unroll
      for (int i = 0; i < 8; ++i) { const int p = tid + 512 * i, key = p >> 4, c = p & 15;
        kin[i] = *(const GAS v4u*)(Kh + (size_t)key * 512 + c * 8); vin[i] = *(const GAS v4u*)(Vh + (size_t)key * 512 + c * 8); }
#pragma unroll
      for (int i = 0; i < 8; ++i) { const int p = tid + 512 * i, key = p >> 4, c = p & 15;
        v4u kv = kin[i]; const v4u vv = vin[i];
        float ss = sumsq8(kv); ss += swz_xor<1>(ss); ss += swz_xor<2>(ss); ss += swz_xor<4>(ss); ss += swz_xor<8>(ss);
        kv = scale8(kv, 1.f / sqrtf(ss * (1.f / 128.f) + EPS), gkr);
        *(LAS v4u*)(lds + c * 4096 + key * 16) = kv;
        *(LAS v4u*)(lds + 65536 + ((c >> 2) * 16 + (key >> 4)) * 1024 + (key & 15) * 64 + (c & 3) * 16) = vv; } }
    const size_t qrow = (size_t)b * SEQ + qb * 256 + wid * 32;
    bf16x8 qr[8];
    { v4u qw[8]; float ss = 0.f;
#pragma unroll
      for (int d0 = 0; d0 < 8; ++d0) { qw[d0] = *(const GAS v4u*)(Q + (qrow + r32) * 512 + h * 128 + d0 * 16 + hi * 8); ss += sumsq8(qw[d0]); }
      ss += other_half(ss, hi);
      const float rstd = (0.08838834764831845f * LOG2E) / sqrtf(ss * (1.f / 128.f) + EPS);
#pragma unroll
      for (int d0 = 0; d0 < 8; ++d0) { float g[8];
#pragma unroll
          for (int j = 0; j < 8; ++j) g[j] = gq[d0 * 16 + hi * 8 + j];
          qr[d0] = __builtin_bit_cast(bf16x8, scale8(qw[d0], rstd, g)); } }
    __syncthreads();
    const LAS unsigned char* kb = lds + hi * 4096 + r32 * 16;
    float mx;
    { float ga = fmaxf(fabsf(gq[lane]), fabsf(gq[64 + lane])), gb = fmaxf(fabsf(gk[lane]), fabsf(gk[64 + lane]));
      ga = fmaxf(ga, swz_xor<1>(ga)); ga = fmaxf(ga, swz_xor<2>(ga)); ga = fmaxf(ga, swz_xor<4>(ga)); ga = fmaxf(ga, swz_xor<8>(ga)); ga = fmaxf(ga, swz_xor<16>(ga)); ga = fmaxf(ga, other_half(ga, hi));
      gb = fmaxf(gb, swz_xor<1>(gb)); gb = fmaxf(gb, swz_xor<2>(gb)); gb = fmaxf(gb, swz_xor<4>(gb)); gb = fmaxf(gb, swz_xor<8>(gb)); gb = fmaxf(gb, swz_xor<16>(gb)); gb = fmaxf(gb, other_half(gb, hi));
      mx = 128.f * ga * gb * (0.08838834764831845f * LOG2E) * 1.01f; }
    if (mx > 60.f) {
        mx = -INFINITY;
#pragma unroll 1
        for (int kblk = 0; kblk < 8; ++kblk) { f32x16 s = f32x16{};
#pragma unroll
            for (int d0 = 0; d0 < 8; ++d0) s = __builtin_amdgcn_mfma_f32_32x32x16_bf16(*(const LAS bf16x8*)(kb + d0 * 8192 + kblk * 512), qr[d0], s, 0, 0, 0);
#pragma unroll
            for (int r = 0; r < 16; ++r) mx = fmaxf(mx, s[r]); }
        mx = fmaxf(mx, other_half(mx, hi)); }
    float l = 0.f; f32x16 o[4]; o[0] = f32x16{}; o[1] = f32x16{}; o[2] = f32x16{}; o[3] = f32x16{};
    const LAS unsigned char* vb = lds + 65536 + ((lane >> 4) & 1) * 32 + (lane & 3) * 8 + (4 * hi + ((lane & 15) >> 2)) * 64;
#pragma unroll 1
    for (int kblk = 0; kblk < 8; ++kblk) { f32x16 s = f32x16{};
#pragma unroll
        for (int d0 = 0; d0 < 8; ++d0) s = __builtin_amdgcn_mfma_f32_32x32x16_bf16(*(const LAS bf16x8*)(kb + d0 * 8192 + kblk * 512), qr[d0], s, 0, 0, 0);
        unsigned pw[8];
#pragma unroll
        for (int r = 0; r < 16; r += 2) { const float p0 = ex2(s[r] - mx), p1 = ex2(s[r + 1] - mx); l += p0 + p1; pw[r >> 1] = cvt_pk_bf16(p0, p1); }
#pragma unroll
        for (int ks = 0; ks < 2; ++ks) { const int kg = kblk * 2 + ks;
            const bf16x8 pa = __builtin_bit_cast(bf16x8, (v4u){pw[4 * ks], pw[4 * ks + 1], pw[4 * ks + 2], pw[4 * ks + 3]});
#pragma unroll
            for (int d0 = 0; d0 < 4; ++d0) { const s16x4 lo = vtr(vb + d0 * 16384 + kg * 1024), hh = vtr(vb + d0 * 16384 + kg * 1024 + 512);
                o[d0] = __builtin_amdgcn_mfma_f32_32x32x16_bf16(pa, MK8(lo, hh), o[d0], 0, 0, 0); } }
    }
    l += other_half(l, hi);
    LAS float* wsf = (LAS float*)(lds + XS_OFF) + wid * 32;
    if (hi == 0) wsf[r32] = 1.f / l;
    __syncthreads();
    { LAS bf16* stg = (LAS bf16*)(lds + wid * 8192);
#pragma unroll
      for (int r = 0; r < 16; ++r) { const int orow = crow(r, hi); const float rl = wsf[orow];
#pragma unroll
          for (int d0 = 0; d0 < 4; ++d0) stg[orow * 128 + d0 * 32 + r32] = (bf16)f2bf(o[d0][r] * rl); }
      LDS_WAIT();
      bf16* Ow = O + qrow * 1536 + h * 128;
#pragma unroll
      for (int i = 0; i < 8; ++i) { const int row = i * 4 + (lane >> 4), ch = lane & 15; const v4u v = *(const LAS v4u*)(stg + row * 128 + ch * 8); *(GAS v4u*)(Ow + (size_t)row * 1536 + ch * 8) = v; } }
    __syncthreads();
}

__device__ __forceinline__ int vimg_off(int row, int col, int nkg) { return (col >> 5) * (nkg * 1024) + (row >> 4) * 1024 + (row & 15) * 64 + (col & 31) * 2; }

__device__ __forceinline__ void gla_cumsum(const float (&la)[8]  , int w, int d, LAS float* cumw, float (&cum)[8], float& last) {
    float c = 0.f;
#pragma unroll
    for (int i = 0; i < 8; ++i) { c += la[i]; cum[i] = c; }
    cumw[w * 64 + d] = c;
    __syncthreads();
    float off = 0.f, tot = 0.f;
#pragma unroll
    for (int j = 0; j < 8; ++j) { const float x = cumw[j * 64 + d]; tot += x; off += (j < w) ? x : 0.f; }
#pragma unroll
    for (int i = 0; i < 8; ++i) cum[i] += off;
    last = tot;
}

__device__ __forceinline__ void gla_stage1_unit(LAS unsigned char* lds, int unit, const bf16* GK, const bf16* GV, const float* LOGA, float* KV, float* DEC, const int w) {
    const int lane = lane_fresh(), tid = w * 64 + lane, r32 = lane & 31, hi = lane >> 5;
    const int bh = unit >> 6, n = unit & 63, b = bh >> 2, h = bh & 3; const size_t row0 = (size_t)b * SEQ + n * 64;
    LAS float* cumw = (LAS float*)(lds + XS_OFF);
    LAS unsigned char* KE = lds; LAS unsigned char* VI = lds + 8192;
    v4u vreg[2]; unsigned short kraw[8]; float la[8];
#pragma unroll
    for (int i = 0; i < 2; ++i) { const int p = tid + 512 * i, j = p >> 4, c = p & 15; vreg[i] = *(const GAS v4u*)(GV + (row0 + j) * 512 + h * 128 + c * 8); }
#pragma unroll
    for (int i = 0; i < 8; ++i) { const size_t o_ = (row0 + 8 * w + i) * 256 + h * 64 + lane; kraw[i] = *(const GAS unsigned short*)(GK + o_); la[i] = *(const GAS float*)(LOGA + o_); }
#pragma unroll
    for (int i = 0; i < 2; ++i) { const int p = tid + 512 * i, j = p >> 4, c = p & 15; *(LAS v4u*)(VI + vimg_off(j, c * 8, 4)) = vreg[i]; }
    float cum[8], last;
    gla_cumsum(la, w, lane, cumw, cum, last);
#pragma unroll
    for (int i = 0; i < 8; ++i) *(LAS bf16*)(KE + vimg_off(8 * w + i, lane, 4)) = (bf16)f2bf(bf2f(kraw[i]) * __expf(last - cum[i]));
    if (w == 0) DEC[(size_t)unit * 64 + lane] = __expf(last);
    __syncthreads();
    const int db = w >> 2, vb = w & 3;
    const int fo = ((lane >> 4) & 1) * 32 + (lane & 3) * 8 + (4 * hi + ((lane & 15) >> 2)) * 64;
    f32x16 acc = f32x16{};
#pragma unroll
    for (int ks = 0; ks < 4; ++ks) {
        const s16x4 al = vtr(KE + fo + db * 4096 + ks * 1024), ah = vtr(KE + fo + db * 4096 + ks * 1024 + 512);
        const s16x4 bl = vtr(VI + fo + vb * 4096 + ks * 1024), bh_ = vtr(VI + fo + vb * 4096 + ks * 1024 + 512);
        acc = __builtin_amdgcn_mfma_f32_32x32x16_bf16(MK8(al, ah), MK8(bl, bh_), acc, 0, 0, 0); }
    float* kvp = KV + (size_t)unit * 8192 + vb * 32 + r32;
#pragma unroll
    for (int r = 0; r < 16; ++r) kvp[(size_t)(32 * db + crow(r, hi)) * 128] = acc[r];
    __syncthreads();
}

__device__ __forceinline__ void gla_scan(const Frame& F, const float* __restrict__ KV, const float* __restrict__ DEC, bf16* __restrict__ STATE) {
    const int tid = F.wave * 64 + lane_fresh();
    for (int gid = F.vcu * 512 + tid; gid < 16 * 8192; gid += F.G * 512) {
        const int bh = gid >> 13, e = gid & 8191, d = e >> 7, v = e & 127; float S = 0.f;
        const int so = vimg_off(d, v, 4) >> 1;
        const float* kvp = KV + (size_t)bh * 64 * 8192 + e; const float* dp = DEC + (size_t)bh * 64 * 64 + d; bf16* sp = STATE + (size_t)bh * 64 * 8192 + so;
#pragma unroll 1
        for (int n0 = 0; n0 < 64; n0 += 16) {
            float kv[16], dc[16];
#pragma unroll
            for (int i = 0; i < 16; ++i) { kv[i] = kvp[(size_t)(n0 + i) * 8192]; dc[i] = dp[(n0 + i) * 64]; }
#pragma unroll
            for (int i = 0; i < 16; ++i) { sp[(size_t)(n0 + i) * 8192] = (bf16)f2bf(S); S = dc[i] * S + kv[i]; }
        }
    }
}

__device__ __forceinline__ void gla_stage3_unit(LAS unsigned char* lds, int unit, const bf16* GQ, const bf16* GK, const bf16* GV, const float* LOGA, const bf16* STATE, const bf16* GR, const float* og, bf16* OCAT, const int w) {
    const int lane = lane_fresh(), tid = w * 64 + lane, r32 = lane & 31, hi = lane >> 5;
    const int bh = unit >> 6, n = unit & 63, b = bh >> 2, h = bh & 3; const size_t row0 = (size_t)b * SEQ + n * 64;
    LAS float* cumw = (LAS float*)(lds + XS_OFF);
    LAS unsigned char* QD = lds; LAS unsigned char* KI = lds + 9216; LAS unsigned char* VI = lds + 18432; LAS unsigned char* SI = lds + 34816; LAS float* OF = (LAS float*)(lds + 51200);
    v4u vreg[2], sreg[2]; unsigned short qraw[8], kraw[8]; float la[8];
#pragma unroll
    for (int i = 0; i < 2; ++i) { const int p = tid + 512 * i, j = p >> 4, c = p & 15;
        vreg[i] = *(const GAS v4u*)(GV + (row0 + j) * 512 + h * 128 + c * 8); sreg[i] = *(const GAS v4u*)(STATE + (size_t)unit * 8192 + p * 8); }
#pragma unroll
    for (int i = 0; i < 8; ++i) { const size_t o_ = (row0 + 8 * w + i) * 256 + h * 64 + lane; qraw[i] = *(const GAS unsigned short*)(GQ + o_); kraw[i] = *(const GAS unsigned short*)(GK + o_); la[i] = *(const GAS float*)(LOGA + o_); }
    const float g0 = *(const GAS float*)(og + 2 * lane), g1 = *(const GAS float*)(og + 2 * lane + 1);
    unsigned grr[8];
#pragma unroll
    for (int i = 0; i < 8; ++i) { const size_t gro = (row0 + 8 * w + i) * 512 + h * 128 + 2 * lane; grr[i] = *(const GAS unsigned*)(GR + gro); }
#pragma unroll
    for (int i = 0; i < 2; ++i) { const int p = tid + 512 * i, j = p >> 4, c = p & 15; *(LAS v4u*)(VI + vimg_off(j, c * 8, 4)) = vreg[i]; *(LAS v4u*)(SI + p * 16) = sreg[i]; }
    float qf[8], kf[8];
#pragma unroll
    for (int i = 0; i < 8; ++i) { qf[i] = bf2f(qraw[i]); kf[i] = bf2f(kraw[i]); }
    float cum[8], last;
    gla_cumsum(la, w, lane, cumw, cum, last);
#pragma unroll
    for (int i = 0; i < 8; ++i) { const float ec = __expf(cum[i]);
        *(LAS bf16*)(QD + (8 * w + i) * 144 + lane * 2) = (bf16)f2bf(qf[i] * 0.125f * ec);
        *(LAS bf16*)(KI + (8 * w + i) * 144 + lane * 2) = (bf16)f2bf(kf[i] * __expf(-cum[i])); }
    __syncthreads();
    const int ib = w >> 2, vb = w & 3;
    unsigned pw[16];
#pragma unroll
    for (int jb = 0; jb < 2; ++jb) {
        f32x16 st = f32x16{};
        if (jb <= ib) {
#pragma unroll
            for (int d0 = 0; d0 < 4; ++d0) {
                const bf16x8 a = *(const LAS bf16x8*)(KI + (32 * jb + r32) * 144 + (16 * d0 + 8 * hi) * 2), bq = *(const LAS bf16x8*)(QD + (32 * ib + r32) * 144 + (16 * d0 + 8 * hi) * 2);
                st = __builtin_amdgcn_mfma_f32_32x32x16_bf16(a, bq, st, 0, 0, 0); }
        }
#pragma unroll
        for (int r = 0; r < 16; r += 2) { const int j0 = 32 * jb + crow(r, hi), i_ = 32 * ib + r32;
            const float p0 = (j0 <= i_) ? st[r] : 0.f, p1 = (j0 + 1 <= i_) ? st[r + 1] : 0.f; pw[jb * 8 + (r >> 1)] = cvt_pk_bf16(p0, p1); }
    }
    const int fo = ((lane >> 4) & 1) * 32 + (lane & 3) * 8 + (4 * hi + ((lane & 15) >> 2)) * 64;
    f32x16 o = f32x16{};
#pragma unroll
    for (int kg = 0; kg < 4; ++kg) {
        const bf16x8 pa = __builtin_bit_cast(bf16x8, (v4u){pw[4 * kg], pw[4 * kg + 1], pw[4 * kg + 2], pw[4 * kg + 3]});
        const s16x4 vl = vtr(VI + fo + vb * 4096 + kg * 1024), vh = vtr(VI + fo + vb * 4096 + kg * 1024 + 512);
        o = __builtin_amdgcn_mfma_f32_32x32x16_bf16(pa, MK8(vl, vh), o, 0, 0, 0);
        const v2u q0 = *(const LAS v2u*)(QD + (32 * ib + r32) * 144 + (16 * kg + 4 * hi) * 2), q1 = *(const LAS v2u*)(QD + (32 * ib + r32) * 144 + (16 * kg + 8 + 4 * hi) * 2);
        const bf16x8 qa = __builtin_bit_cast(bf16x8, (v4u){q0.x, q0.y, q1.x, q1.y});
        const s16x4 sl = vtr(SI + fo + vb * 4096 + kg * 1024), sh = vtr(SI + fo + vb * 4096 + kg * 1024 + 512);
        o = __builtin_amdgcn_mfma_f32_32x32x16_bf16(qa, MK8(sl, sh), o, 0, 0, 0);
    }
#pragma unroll
    for (int r = 0; r < 16; ++r) OF[(32 * ib + crow(r, hi)) * 132 + 32 * vb + r32] = o[r];
    __syncthreads();
#pragma unroll
    for (int i = 0; i < 8; ++i) { const int row = 8 * w + i; const f32x2_t xx = *(const LAS f32x2_t*)(OF + row * 132 + 2 * lane); const float x0 = xx.x, x1 = xx.y;
        const float rstd = __builtin_amdgcn_rsqf(wave_sum(x0 * x0 + x1 * x1, hi) * (1.f / 128.f) + EPS);
        const size_t oo = (row0 + row) * 1536 + 512 + h * 128 + 2 * lane;
        *(GAS unsigned*)(OCAT + oo) = pk2(x0 * rstd * g0 * bflo(grr[i]), x1 * rstd * g1 * bfhi(grr[i])); }
    __syncthreads();
}

__device__ __forceinline__ void phase_route(const Frame& F, const bf16* x, const float* gain, const float* wr  , unsigned* gcnt  , unsigned* ROUTE) {
    LAS unsigned* cntl = (LAS unsigned*)(F.lds); LAS unsigned* gb = cntl + 8; LAS unsigned* tok = cntl + 16;
    const int lane = lane_fresh(), w = F.wave, tid = w * 64 + lane;
    f32x4 wq[16][2];
#pragma unroll
    for (int j = 0; j < 4; ++j)
#pragma unroll
        for (int c = 0; c < 4; ++c) { const GAS f32x4* wp = (const GAS f32x4*)(wr + (size_t)(256 * j + 4 * lane + c) * 8); wq[4 * j + c][0] = wp[0]; wq[4 * j + c][1] = wp[1]; }
    f32x4 gq4[4];
#pragma unroll
    for (int j = 0; j < 4; ++j) gq4[j] = *((const GAS f32x4*)gain + lane + 64 * j);
    for (int blk = F.vcu; blk < MTOK / 64; blk += F.G) {
        if (tid < 8) cntl[tid] = 0u;
        __syncthreads();
        f32x4 vn[4];
#pragma unroll
        for (int j = 0; j < 4; ++j) vn[j] = ldx4<true>(x + (size_t)(blk * 64 + w * 8) * XBP, lane + 64 * j);
#pragma unroll 1
        for (int i = 0; i < 8; ++i) {
            const int m = blk * 64 + w * 8 + i;
            f32x4 v[4]; float s = 0.f;
#pragma unroll
            for (int j = 0; j < 4; ++j) { v[j] = vn[j]; s += (v[j].x * v[j].x + v[j].y * v[j].y) + (v[j].z * v[j].z + v[j].w * v[j].w); }
            if (i < 7) {
#pragma unroll
                for (int j = 0; j < 4; ++j) vn[j] = ldx4<true>(x + (size_t)(m + 1) * XBP, lane + 64 * j); }
            const float rstd = 1.f / sqrtf(wave_sum(s, lane >> 5) * (1.f / 1024.f) + EPS);
            float lg[8];
#pragma unroll
            for (int e = 0; e < 8; ++e) lg[e] = 0.f;
            GAS unsigned* o4 = (GAS unsigned*)(wsp<unsigned char>(F, WS_HBUF) + (size_t)m * 1024) + lane;
#pragma unroll
            for (int j = 0; j < 4; ++j) { const f32x4 y = v[j] * rstd * gq4[j];
                o4[64 * j] = pk4_fp8(y.x, y.y, y.z, y.w);
#pragma unroll
                for (int c = 0; c < 4; ++c) { const f32x4 w0 = wq[4 * j + c][0], w1 = wq[4 * j + c][1]; const float yc = y[c];
                    lg[0] += yc * w0.x; lg[1] += yc * w0.y; lg[2] += yc * w0.z; lg[3] += yc * w0.w; lg[4] += yc * w1.x; lg[5] += yc * w1.y; lg[6] += yc * w1.z; lg[7] += yc * w1.w; } }
#pragma unroll
            for (int e = 0; e < 8; ++e) lg[e] = wave_sum(lg[e], lane >> 5);
            if (lane == 0) {
                int e1 = 0; float v1 = lg[0];
#pragma unroll
                for (int e = 1; e < 8; ++e) if (lg[e] > v1) { v1 = lg[e]; e1 = e; }
                int e2 = -1; float v2 = -INFINITY;
#pragma unroll
                for (int e = 0; e < 8; ++e) if (e != e1 && lg[e] > v2) { v2 = lg[e]; e2 = e; }
                const float w2 = 1.f / (1.f + __expf(v1 - v2)), w1 = 1.f - w2;
                const unsigned p1 = atomicAdd((unsigned*)(cntl + e1), 1u), p2 = atomicAdd((unsigned*)(cntl + e2), 1u);
                LAS unsigned* t = tok + (w * 8 + i) * 6; t[0] = (unsigned)e1; t[1] = p1; t[2] = (unsigned)e2; t[3] = p2; t[4] = __float_as_uint(w1); t[5] = __float_as_uint(w2);
            }
        }
        __syncthreads();
        if (tid < 8) gb[tid] = __hip_atomic_fetch_add(gcnt + tid * 64, cntl[tid], __ATOMIC_RELAXED, __HIP_MEMORY_SCOPE_AGENT);
        __syncthreads();
        if (tid < 64) { LAS unsigned* t = tok + tid * 6; unsigned* r = ROUTE + (size_t)(blk * 64 + tid) * 8;
            r[0] = t[0]; r[1] = gb[t[0]] + t[1]; r[2] = t[2]; r[3] = gb[t[2]] + t[3]; r[4] = t[4]; r[5] = t[5]; }
        __syncthreads();
    }
}
__device__ __forceinline__ void moe_tile_starts(const unsigned* gcnt, int (&rs)[8]) {
    int t = 0;
#pragma unroll
    for (int e = 0; e < 8; ++e) { rs[e] = t * 256; t += ((int)gcnt[e * 64] + 255) >> 8; }
}
__device__ __forceinline__ void phase_scatter(const Frame& F, const unsigned* gcnt, unsigned* ROUTE) {
    int rs[8]; moe_tile_starts(gcnt, rs);
    const int gw = F.vcu * 8 + F.wave, NGW = F.G * 8, lane = lane_fresh();
    const unsigned char* H = wsp<unsigned char>(F, WS_HBUF); unsigned char* AS = wsp<unsigned char>(F, WS_ASORT);
    for (int m0 = gw; m0 < MTOK; m0 += 4 * NGW) {
        v4u rt[4], a[4];
#pragma unroll
        for (int k = 0; k < 4; ++k) { const int m = m0 + k * NGW; if (m < MTOK) { rt[k] = *(const GAS v4u*)(ROUTE + (size_t)m * 8); a[k] = *((const GAS v4u*)(H + (size_t)m * 1024) + lane); } }
#pragma unroll
        for (int k = 0; k < 4; ++k) { const int m = m0 + k * NGW; if (m < MTOK) {
            const unsigned e1 = rt[k].x, p1 = rt[k].y, e2 = rt[k].z, p2 = rt[k].w; int b1 = 0, b2 = 0;
#pragma unroll
            for (int e = 0; e < 8; ++e) { b1 = (e1 == (unsigned)e) ? rs[e] : b1; b2 = (e2 == (unsigned)e) ? rs[e] : b2; }
            const unsigned s1 = (unsigned)b1 + p1, s2 = (unsigned)b2 + p2;
            *((GAS v4u*)(AS + (size_t)s1 * 1024) + lane) = a[k]; *((GAS v4u*)(AS + (size_t)s2 * 1024) + lane) = a[k];
            if (lane == 0) { unsigned* r = ROUTE + (size_t)m * 8; r[6] = s1; r[7] = s2; } } }
    }
}
__device__ __forceinline__ v4u ypart_sum(const bf16* YP, unsigned prow, int lane, int j) {
    float a[8]; v4u q[pg8::GroupedOrder::KSPL];
#pragma unroll
    for (int i = 0; i < 8; ++i) a[i] = 0.f;
#pragma unroll
    for (int ks = 0; ks < pg8::GroupedOrder::KSPL; ++ks) q[ks] = *((const GAS v4u*)(YP + ((size_t)ks * YPART_ROWS + prow) * 1024) + lane + 64 * j);
#pragma unroll
    for (int ks = 0; ks < pg8::GroupedOrder::KSPL; ++ks) { const v4u p = q[ks];
        a[0] += bflo(p.x); a[1] += bfhi(p.x); a[2] += bflo(p.y); a[3] += bfhi(p.y); a[4] += bflo(p.z); a[5] += bfhi(p.z); a[6] += bflo(p.w); a[7] += bfhi(p.w); }
    v4u o; o.x = pk2(a[0], a[1]); o.y = pk2(a[2], a[3]); o.z = pk2(a[4], a[5]); o.w = pk2(a[6], a[7]); return o;
}
__device__ __forceinline__ void phase_combine(const Frame& F, const unsigned* gcnt, const unsigned* ROUTE, const bf16* xb, float* out) {
    const int gw = F.vcu * 8 + F.wave, NGW = F.G * 8, lane = lane_fresh();
    const bf16* Y = wsp<bf16>(F, WS_YBUF); const bf16* YP = wsp<bf16>(F, WS_YPART);
    unsigned split0;
    { int t = 0;
#pragma unroll
      for (int e = 0; e < 8; ++e) t += ((int)gcnt[e * 64] + 255) >> 8;
      split0 = (unsigned)pg8::GroupedOrder::main_tiles(t, 4, F.G) * 256u; }
    for (int m0 = gw; m0 < MTOK; m0 += 4 * NGW) {
        v4u rt[4];
#pragma unroll
        for (int k = 0; k < 4; ++k) { const int m = m0 + k * NGW; if (m < MTOK) rt[k] = *((const GAS v4u*)(ROUTE + (size_t)m * 8) + 1); }
        v4u ya[4][2], yc[4][2]; f32x4 o[4][4];
#pragma unroll
        for (int k = 0; k < 4; ++k) { const int m = m0 + k * NGW; if (m < MTOK) {
            const GAS v4u* y1 = (const GAS v4u*)(Y + (size_t)rt[k].z * YBP) + lane; const GAS v4u* y2 = (const GAS v4u*)(Y + (size_t)rt[k].w * YBP) + lane;
            const GAS v4u* xp = (const GAS v4u*)(xb + (size_t)m * XBP) + lane;
#pragma unroll
            for (int j = 0; j < 2; ++j) { ya[k][j] = y1[64 * j]; yc[k][j] = y2[64 * j]; const v4u xw = xp[64 * j];
                o[k][2 * j] = (f32x4){bflo(xw.x), bfhi(xw.x), bflo(xw.y), bfhi(xw.y)}; o[k][2 * j + 1] = (f32x4){bflo(xw.z), bfhi(xw.z), bflo(xw.w), bfhi(xw.w)}; } } }
#pragma unroll
        for (int k = 0; k < 4; ++k) { const int m = m0 + k * NGW; if (m < MTOK) {
            if (rt[k].z >= split0) { ya[k][0] = ypart_sum(YP, rt[k].z - split0, lane, 0); ya[k][1] = ypart_sum(YP, rt[k].z - split0, lane, 1); }
            if (rt[k].w >= split0) { yc[k][0] = ypart_sum(YP, rt[k].w - split0, lane, 0); yc[k][1] = ypart_sum(YP, rt[k].w - split0, lane, 1); } } }
#pragma unroll
        for (int k = 0; k < 4; ++k) { const int m = m0 + k * NGW; if (m < MTOK) {
            const float w1 = __uint_as_float(rt[k].x), w2 = __uint_as_float(rt[k].y);
            GAS f32x4* op = (GAS f32x4*)(out + (size_t)m * 1024) + 2 * lane;
#pragma unroll
            for (int j = 0; j < 2; ++j) { const v4u a = ya[k][j], c = yc[k][j]; f32x4 o0 = o[k][2 * j], o1 = o[k][2 * j + 1];
                o0.x += w1 * bflo(a.x) + w2 * bflo(c.x); o0.y += w1 * bfhi(a.x) + w2 * bfhi(c.x); o0.z += w1 * bflo(a.y) + w2 * bflo(c.y); o0.w += w1 * bfhi(a.y) + w2 * bfhi(c.y);
                o1.x += w1 * bflo(a.z) + w2 * bflo(c.z); o1.y += w1 * bfhi(a.z) + w2 * bfhi(c.z); o1.z += w1 * bflo(a.w) + w2 * bflo(c.w); o1.w += w1 * bfhi(a.w) + w2 * bfhi(c.w);
                op[128 * j] = o0; op[128 * j + 1] = o1; } } }
    }
}

constexpr int N_PHASES = 25;
struct Args { const float* in[N_IN]; float* out; unsigned char* ws; int ph_lo, ph_hi; };
static_assert(sizeof(Args) == N_IN * 8 + 8 + 8 + 8, "Args has no padding");

__global__ void __launch_bounds__(512, 2) mega_fwd(Args args) {
    extern __shared__ __attribute__((aligned(16))) unsigned char lds_raw[];
    Frame F;
    F.lds = (LAS unsigned char*)lds_raw;
    F.wave = __builtin_amdgcn_readfirstlane((int)threadIdx.x >> 6);
    F.G = gridDim.x; { const int bx = blockIdx.x; F.vcu = (F.G % 8 == 0) ? (bx % 8) * (F.G / 8) + bx / 8 : bx; }
    F.ws = args.ws; F.in = args.in; F.out = args.out;
    gu32* ctl = (gu32*)(F.ws + WS_CTL);
    volatile LAS unsigned* MISC = (volatile LAS unsigned*)(F.lds + MISC_OFF);
    for (int u = threadIdx.x; u < (XS_OFF - LDSCTL_OFF) / 4; u += 512) ((LAS unsigned*)(F.lds + LDSCTL_OFF))[u] = 0u;
    __syncthreads();
    const int lo = args.ph_lo, hi = args.ph_hi;
    XcdBarrier bar; bar.bar = (unsigned*)(ctl + CW_BAR); bar.x = 0; bar.st = nullptr;
    if (MK_ONE_LAUNCH || hi - lo > 1) bar = xcd_barrier_post((unsigned*)(ctl + CW_BAR), MISC + 8);
#ifndef DBG_MASK
#define DBG_MASK 0xFFFFFFFFu
#endif
#define ON(i) (((DBG_MASK) >> (i)) & 1u)
#if MK_ONE_LAUNCH
#define IN(k) true
#define SEAM(k) xcd_barrier(bar, F.wave == 0 && lane_fresh() == 0)
#else
#define IN(k) (lo <= (k) && (k) < hi)
#define SEAM(k) do { if (IN(k) && IN((k) + 1)) xcd_barrier(bar, F.wave == 0 && lane_fresh() == 0); } while (0)
#endif

    if (ON(0) && IN(0)) { phase_prologue(F); }
    SEAM(0);
    const Frame F0 = F;
#pragma unroll 1
    for (int l = 0; l < 2; ++l) {
        const int pb = 1 + 12 * l;
        Frame F = F0; int bidx = blockIdx.x;
        asm volatile("" : "+s"(F.G), "+s"(F.vcu), "+s"(bidx), "+s"(F.ws), "+s"(F.wave));
        bf16* HB = wsp<bf16>(F, WS_HBUF);
        if (IN(pb + 0)) {
            if (ON(1)) {
              { pg8::Gemm g{HB, wsp<bf16>(F, WS_WIN) + (size_t)l * IN_WP * 1024, MTOK, 3840, 1024, 0}; pg8::StaticOrder S; S.init(MTOK, 3840, F.G, bidx);
                epi::EpiInProj E{wsp<bf16>(F, WS_SBQ), wsp<bf16>(F, WS_SBK), wsp<bf16>(F, WS_SBV), wsp<bf16>(F, WS_GQ), wsp<bf16>(F, WS_GK), wsp<bf16>(F, WS_GV), wsp<bf16>(F, WS_GR), wsp<bf16>(F, WS_CAQ), wsp<bf16>(F, WS_GATES),
                                  wsp<float>(F, WS_LOGA), F.in[I_GAB] + l * 256, 1.f};
                pg8::gemm_phase<epi::EpiInProj, pg8::StaticOrder, true, PG8_SP2>(F.lds, g, S, E, F.wave); }
              { pg8::Gemm g{wsp<bf16>(F, WS_HB8), (const bf16*)(wsp<unsigned char>(F, WS_WIN) + (size_t)l * IN_WP * 2048 + (size_t)3840 * 2048), MTOK, 3072, 512, 0}; pg8::StaticOrder S; S.init(MTOK, 3072, F.G, bidx);
                epi::EpiGates E{wsp<bf16>(F, WS_GATES), 1.f / 32.f};
                pg8::gemm_phase<epi::EpiGates, pg8::StaticOrder, true, PG8_SP2, 1>(F.lds, g, S, E, F.wave); } }
            if (ON(2) && l == 0) {
#pragma unroll 1
                for (int l2 = 0; l2 < 2; ++l2) {
                    pg8::Gemm g{wsp<bf16>(F, WS_HMEM) + (size_t)l2 * MMEM * 1024, wsp<bf16>(F, WS_WMKV) + (size_t)l2 * 1024 * 1024, MMEM, 1024, 1024, 0}; pg8::StaticOrder S;
                    S.init(MMEM, 1024, F.G, (bidx - (960 % F.G) - 16 * l2 + 2 * F.G) % F.G);
                    epi::EpiBf16Split E{wsp<bf16>(F, WS_MK) + (size_t)l2 * MMEM * 512, wsp<bf16>(F, WS_MV) + (size_t)l2 * MMEM * 512, 512, 2, 1.f};
                    pg8::gemm_phase<epi::EpiBf16Split, pg8::StaticOrder, true, PG8_SP2>(F.lds, g, S, E, F.wave); }
            }
        }
        SEAM(pb + 0);
        if (IN(pb + 2)) {
            if (ON(4)) for (int rep = 0; rep < DBG_REP_SB; ++rep) for (int p = F.vcu; p < 256; p += F.G) { const int bh = p >> 3, s = p & 7;
                sb_attn_unit(F.lds, bh >> 3, bh & 7, 15 - s, wsp<bf16>(F, WS_SBQ), wsp<bf16>(F, WS_SBK), wsp<bf16>(F, WS_SBV), wsp<bf16>(F, WS_OCAT), F.in[I_SBQG] + l * 64, F.in[I_SBKG] + l * 64, F.wave);
                sb_attn_unit(F.lds, bh >> 3, bh & 7, s, wsp<bf16>(F, WS_SBQ), wsp<bf16>(F, WS_SBK), wsp<bf16>(F, WS_SBV), wsp<bf16>(F, WS_OCAT), F.in[I_SBQG] + l * 64, F.in[I_SBKG] + l * 64, F.wave); }
            if (ON(5)) for (int u = F.vcu; u < 256; u += F.G)
                ca_unit(F.lds, u >> 6, (u >> 4) & 3, u & 15, wsp<bf16>(F, WS_CAQ), wsp<bf16>(F, WS_MK) + (size_t)l * MMEM * 512, wsp<bf16>(F, WS_MV) + (size_t)l * MMEM * 512, wsp<bf16>(F, WS_OCAT) + 1024, F.in[I_CAQG] + l * 128, F.in[I_CAKG] + l * 128, F.wave);
            if (ON(6)) for (int u = F.vcu; u < 1024; u += F.G)
                gla_stage1_unit(F.lds, u, wsp<bf16>(F, WS_GK), wsp<bf16>(F, WS_GV), wsp<float>(F, WS_LOGA), wsp<float>(F, WS_KV), wsp<float>(F, WS_DEC), F.wave);
        }
        SEAM(pb + 2);
        if (ON(7) && IN(pb + 3)) gla_scan(F, wsp<float>(F, WS_KV), wsp<float>(F, WS_DEC), wsp<bf16>(F, WS_STATE));
        SEAM(pb + 3);
        if (ON(8) && IN(pb + 4)) {
            for (int u = F.vcu; u < 1024; u += F.G)
                gla_stage3_unit(F.lds, u, wsp<bf16>(F, WS_GQ), wsp<bf16>(F, WS_GK), wsp<bf16>(F, WS_GV), wsp<float>(F, WS_LOGA), wsp<bf16>(F, WS_STATE), wsp<bf16>(F, WS_GR), F.in[I_GOG] + l * 128, wsp<bf16>(F, WS_OCAT), F.wave);
        }
        SEAM(pb + 4);
        if (ON(9) && IN(pb + 5)) {
            pg8::Gemm g{wsp<bf16>(F, WS_OCAT), wsp<bf16>(F, WS_WBR) + (size_t)l * 1024 * 1536, MTOK, 1024, 1536, 0}; pg8::StaticOrder S; S.init(MTOK, 1024, F.G, bidx);
            epi::EpiBranch E{wsp<bf16>(F, WS_GATES), wsp<bf16>(F, WS_MERGED)};
            pg8::gemm_phase<epi::EpiBranch, pg8::StaticOrder, false, PG8_SP2>(F.lds, g, S, E, F.wave);
        }
        SEAM(pb + 5);
        if (ON(10) && IN(pb + 6)) {
            pg8::Gemm g{wsp<bf16>(F, WS_MERGED), wsp<bf16>(F, WS_WOUT) + (size_t)l * 1024 * 1024, MTOK, 1024, 1024, 0, MGP}; pg8::StaticOrder S; S.init(MTOK, 1024, F.G, bidx);
            epi::EpiResF32 E{l == 0 ? (const void*)F.in[I_X] : (const void*)wsp<bf16>(F, WS_XB), l != 0, wsp<bf16>(F, WS_XB), 1.f};
            pg8::gemm_phase<epi::EpiResF32, pg8::StaticOrder, false, PG8_SP2>(F.lds, g, S, E, F.wave);
        }
        SEAM(pb + 6);
        unsigned* gcnt = (unsigned*)(ctl + CW_CNT); unsigned* ROUTE = wsp<unsigned>(F, WS_ROUTE);
        if (l == 0) {
            if (ON(11) && IN(pb + 7)) phase_rms(F, wsp<bf16>(F, WS_XB), F.in[I_FFNG]);
            SEAM(pb + 7);
            if (ON(12) && IN(pb + 9)) {
                pg8::Gemm g{HB, wsp<bf16>(F, WS_WGU0), MTOK, 2 * DFF, 1024, 0}; pg8::StaticOrder S; S.init(MTOK, 2 * DFF, F.G, bidx);
                epi::EpiSwiGLU<true> E{wsp<unsigned char>(F, WS_ACT), DFF, 1.f};
                pg8::gemm_phase<epi::EpiSwiGLU<true>, pg8::StaticOrder, true, PG8_SP2>(F.lds, g, S, E, F.wave);
            }
            SEAM(pb + 9);
            if (ON(13) && IN(pb + 10)) {
                pg8::Gemm g{wsp<bf16>(F, WS_ACT), wsp<bf16>(F, WS_WDN0), MTOK, 1024, DFF / 2, 0}; pg8::StaticOrder S; S.init(MTOK, 1024, F.G, bidx);
                epi::EpiResF32 E{wsp<bf16>(F, WS_XB), 1, wsp<bf16>(F, WS_XB), 1.f / 256.f};
                pg8::gemm_phase<epi::EpiResF32, pg8::StaticOrder, false, PG8_SP2, 1>(F.lds, g, S, E, F.wave);
            }
            SEAM(pb + 10);
            if (ON(11) && IN(pb + 11)) { if (L1_INPROJ_FP8) phase_rms_fp8(F, wsp<bf16>(F, WS_XB), F.in[I_MIXG] + 1024); else phase_rms(F, wsp<bf16>(F, WS_XB), F.in[I_MIXG] + 1024, true); }
            SEAM(pb + 11);
        } else {
            if (ON(14) && IN(pb + 7)) phase_route(F, wsp<bf16>(F, WS_XB), F.in[I_FFNG] + 1024, F.in[I_ROUTER], gcnt, ROUTE);
            SEAM(pb + 7);
            if (ON(15) && IN(pb + 8)) phase_scatter(F, gcnt, ROUTE);
            SEAM(pb + 8);
            if (ON(16) && IN(pb + 9)) {
                pg8::Gemm g{wsp<bf16>(F, WS_ASORT), wsp<bf16>(F, WS_WGUE), 0, 2 * DFFE, 1024 / 2, (size_t)2 * DFFE * 1024}; pg8::GroupedOrder S; S.init(gcnt, 2 * DFFE, F.G, bidx);
                epi::EpiSwiGLU<true> E{wsp<unsigned char>(F, WS_ACT), DFFE, 1.f / 32.f};
                pg8::gemm_phase<epi::EpiSwiGLU<true>, pg8::GroupedOrder, false, PG8_SP2, 1>(F.lds, g, S, E, F.wave);
            }
            SEAM(pb + 9);
            if (ON(17) && IN(pb + 10)) {
                pg8::Gemm g{wsp<bf16>(F, WS_ACT), wsp<bf16>(F, WS_WDNE), 0, 1024, DFFE / 2, (size_t)1024 * DFFE}; pg8::GroupedOrder S; S.init_main(gcnt, 1024, F.G, bidx);
                epi::EpiBf16Split E{wsp<bf16>(F, WS_YBUF), wsp<bf16>(F, WS_YBUF), YBP, 4, 1.f / 256.f};
                pg8::gemm_phase<epi::EpiBf16Split, pg8::GroupedOrder, false, PG8_SP2, 1>(F.lds, g, S, E, F.wave);
                { const int tm = pg8::GroupedOrder::main_tiles(S.ts[8], 4, F.G); const int nsub = (S.ts[8] - tm) * 4 * pg8::GroupedOrder::KSPL;
                  pg8::SingleOrder S1; S1.has = bidx < nsub; const int ks = bidx % pg8::GroupedOrder::KSPL, un = bidx / pg8::GroupedOrder::KSPL;
                  S1.u.pm = tm + (un >> 2); S1.u.pn = un & 3; S1.u.e = S.expert_of(S1.u.pm);
                  constexpr int KSL = DFFE / pg8::GroupedOrder::KSPL;
                  pg8::Gemm g1{(const bf16*)(wsp<unsigned char>(F, WS_ACT) + ks * KSL), (const bf16*)(wsp<unsigned char>(F, WS_WDNE) + ks * KSL), 0, 1024, KSL / 2, (size_t)1024 * DFFE, DFFE / 2, DFFE / 2};
                  bf16* yp = wsp<bf16>(F, WS_YPART) + ((size_t)ks * YPART_ROWS - (size_t)tm * 256) * 1024;
                  epi::EpiBf16Split E1{yp, yp, 1024, 4, 1.f / 256.f};
                  pg8::gemm_phase<epi::EpiBf16Split, pg8::SingleOrder, false, PG8_SP2, 1>(F.lds, g1, S1, E1, F.wave); }
            }
            SEAM(pb + 10);
            if (ON(18) && IN(pb + 11)) phase_combine(F, gcnt, ROUTE, wsp<bf16>(F, WS_XB), F.out);
        }
    }
#undef IN
#undef SEAM
}

__global__ void dbg_dump_bf16(const bf16* src, int ld, int c0, int ncols, float* out, int dc0) {
    const size_t n = (size_t)MTOK * ncols;
    for (size_t i = (size_t)blockIdx.x * blockDim.x + threadIdx.x; i < n; i += (size_t)gridDim.x * blockDim.x) { const size_t m = i / ncols; const int c = (int)(i % ncols);
        out[m * 1024 + dc0 + c] = bf2f(src[m * ld + c0 + c]); }
}
extern "C" void kernel_launch(void* const* d_in, const int* in_sizes, int n_in, void* d_out, int out_size, void* d_ws, size_t ws_size, hipStream_t stream) {
    static int grid = 0;
    if (grid == 0) {
        if (n_in != N_IN || out_size != MTOK * DM || ws_size < WS_END) { fprintf(stderr, "kernel_launch: unexpected shapes: n_in %d out %d ws %zu (need %zu)\n", n_in, out_size, ws_size, (size_t)WS_END); grid = -1; return; }
        int dev = 0, cus = 0, per_cu = 0;
        if (hipGetDevice(&dev) != hipSuccess || hipDeviceGetAttribute(&cus, hipDeviceAttributeMultiprocessorCount, dev) != hipSuccess) { grid = -1; return; }
        if (hipFuncSetAttribute((const void*)mega_fwd, hipFuncAttributeMaxDynamicSharedMemorySize, LDS_BYTES) != hipSuccess) { fprintf(stderr, "kernel_launch: hipFuncSetAttribute failed\n"); grid = -1; return; }
        if (hipOccupancyMaxActiveBlocksPerMultiprocessor(&per_cu, (const void*)mega_fwd, 512, LDS_BYTES) != hipSuccess || per_cu < 1) fprintf(stderr, "kernel_launch: occupancy query says %d\n", per_cu);
        (void)hipGetLastError();
        grid = cus;
    }
    if (grid < 0) return;
    (void)hipMemsetAsync((char*)d_ws + WS_CTL, 0, CTL_ZERO_BYTES, stream);
    Args a{};
    for (int i = 0; i < N_IN; ++i) a.in[i] = (const float*)d_in[i];
    a.out = (float*)d_out; a.ws = (unsigned char*)d_ws;
#if MK_ONE_LAUNCH
    a.ph_lo = 0; a.ph_hi = N_PHASES;
    hipLaunchKernelGGL(mega_fwd, dim3(grid), dim3(512), LDS_BYTES, stream, a);
#else
#ifndef DBG_LAST
#define DBG_LAST N_PHASES
#endif
    for (int ph = 0; ph < DBG_LAST; ++ph) {
        if (ph == 1 + 8 || ph == 2 || ph == 14) continue;
        a.ph_lo = ph; a.ph_hi = ph + 1;
        hipLaunchKernelGGL(mega_fwd, dim3(grid), dim3(512), LDS_BYTES, stream, a);
    }
#ifdef DBG_DUMP
    { unsigned char* ws = (unsigned char*)d_ws; DBG_DUMP }
#endif
#endif
}
```
